# Optimizing an MI355X kernel written in HIP

```python
import jax, jax.numpy as jnp
from jax import lax
import numpy as np

D_MODEL = 1024
BATCH = 2
SEQ = 16384
DEPTH = 2

GRID_W = 64
CTX_LEN = 256
N_MIXERS = 2
N_MOD = 9
D_FF = 2816
GMLP_D_FF = 6 * D_MODEL
GMLP_HALF = GMLP_D_FF // 2
CHUNK = 128
GMLP_GROUPS = 8
HEAD_DIM = 128
N_HEADS = D_MODEL // HEAD_DIM
N_KV_HEADS = 2
Q_DIM = N_HEADS * HEAD_DIM
KV_DIM = N_KV_HEADS * HEAD_DIM
ROPE_THETA = 10000.0
Q_BLOCK = 128
LN_EPS = 1e-5
RMS_EPS = 1e-6
ALPHA = (2.0 * DEPTH) ** 0.25
BETA = (8.0 * DEPTH) ** -0.25
N_A = (DEPTH + 1) // 2
N_B = DEPTH // 2

kernel_name = "hybrid_gmlp_gqa_macaron_deepnorm_dit"


def layer_norm(x, g, b):
    xf = x.astype(jnp.float32)
    mu = jnp.mean(xf, axis=-1, keepdims=True)
    var = jnp.mean(jnp.square(xf - mu), axis=-1, keepdims=True)
    return ((xf - mu) * lax.rsqrt(var + LN_EPS) * g + b).astype(x.dtype)


def rms_norm(x, g):
    xf = x.astype(jnp.float32)
    return (xf * lax.rsqrt(jnp.mean(jnp.square(xf), axis=-1, keepdims=True) + RMS_EPS) * g).astype(x.dtype)


def modulation(cond, w_mod, b_mod):
    m = jax.nn.silu(cond) @ w_mod + b_mod
    return jnp.split(m[..., None, :], N_MOD, axis=-1)


def modulate(x, shift, scale):
    return x * (1.0 + scale) + shift


def swiglu(h, w_in, w_out):
    g, u = jnp.split(h @ w_in, 2, axis=-1)
    return (jax.nn.silu(g) * u) @ w_out


def ffn_sublayer(x, shift, scale, gate, w_in, w_out, ln_g, ln_b):
    y = swiglu(modulate(x, shift, scale), w_in, w_out)
    return layer_norm(ALPHA * x + 0.5 * gate * y, ln_g, ln_b)


def gmlp_mix(h, w_in, sgu_g, sgu_b, w_s, b_s, w_out):
    b_, t_, _ = h.shape
    u, v = jnp.split(jax.nn.gelu(h @ w_in, approximate=False), 2, axis=-1)
    v = layer_norm(v, sgu_g, sgu_b)
    v = v.reshape(b_, t_ // CHUNK, CHUNK, GMLP_GROUPS, GMLP_HALF // GMLP_GROUPS)
    v = jnp.einsum('gpq,bnqgc->bnpgc', w_s, v) + b_s.T[None, None, :, :, None]
    return (u * v.reshape(b_, t_, GMLP_HALF)) @ w_out


def rope_tables(rows, cols):
    quarter = HEAD_DIM // 4
    freqs = ROPE_THETA ** (-jnp.arange(quarter, dtype=jnp.float32) / quarter)
    ang = jnp.concatenate([rows.astype(jnp.float32)[:, None] * freqs,
                           cols.astype(jnp.float32)[:, None] * freqs], axis=-1)
    return jnp.cos(ang), jnp.sin(ang)


def apply_rope(x, cos, sin):
    x1, x2 = jnp.split(x, 2, axis=-1)
    out = jnp.concatenate([x1 * cos - x2 * sin, x2 * cos + x1 * sin], axis=-1)
    return out.astype(x.dtype)


def split_heads(x, n):
    b_, t_, _ = x.shape
    return x.reshape(b_, t_, n, HEAD_DIM).transpose(0, 2, 1, 3)


def merge_heads(x):
    b_, h_, t_, d_ = x.shape
    return x.transpose(0, 2, 1, 3).reshape(b_, t_, h_ * d_)


def attend(q, k, v):
    b_, h_, tq, hd = q.shape
    qg = q.reshape(b_, N_KV_HEADS, h_ // N_KV_HEADS, tq, hd)
    s = jnp.einsum('bkgqd,bktd->bkgqt', qg, k, preferred_element_type=jnp.float32) * (hd ** -0.5)
    p = jax.nn.softmax(s, axis=-1)
    o = jnp.einsum('bkgqt,bktd->bkgqd', p.astype(v.dtype), v)
    return o.reshape(b_, h_, tq, hd)


def block_attend(q, k, v):
    b_, h_, t_, hd = q.shape
    nb = t_ // Q_BLOCK
    qb = q.reshape(b_, h_, nb, Q_BLOCK, hd).transpose(2, 0, 1, 3, 4)
    ob = lax.map(lambda qblk: attend(qblk, k, v), qb)
    return ob.transpose(1, 2, 0, 3, 4).reshape(b_, h_, t_, hd)


def gqa_mix(h_lat, h_ctx, w_qkv, q_norm_g, k_norm_g, w_o, cos, sin, with_ctx_out):
    kv_c = h_ctx @ w_qkv[:, Q_DIM:]
    k_c = rms_norm(split_heads(kv_c[..., :KV_DIM], N_KV_HEADS), k_norm_g)
    v_c = split_heads(kv_c[..., KV_DIM:], N_KV_HEADS)
    qkv = h_lat @ w_qkv
    q_l = apply_rope(rms_norm(split_heads(qkv[..., :Q_DIM], N_HEADS), q_norm_g), cos, sin)
    k_l = apply_rope(rms_norm(split_heads(qkv[..., Q_DIM:Q_DIM + KV_DIM], N_KV_HEADS), k_norm_g), cos, sin)
    v_l = split_heads(qkv[..., Q_DIM + KV_DIM:], N_KV_HEADS)
    k_all = jnp.concatenate([k_c, k_l], axis=2)
    v_all = jnp.concatenate([v_c, v_l], axis=2)
    y_lat = merge_heads(block_attend(q_l, k_all, v_all)) @ w_o
    if not with_ctx_out:
        return y_lat, None
    q_c = rms_norm(split_heads(h_ctx @ w_qkv[:, :Q_DIM], N_HEADS), q_norm_g)
    y_ctx = merge_heads(attend(q_c, k_c, v_c)) @ w_o
    return y_lat, y_ctx


def setup_inputs(seed: int = 0) -> dict:
    key = jax.random.key(seed)
    ks = jax.random.split(key, 20)
    f32 = jnp.float32
    nrm = lambda k, shape, s: jax.random.normal(k, shape, f32) * s
    return {
        "x": nrm(ks[0], (BATCH, SEQ, D_MODEL), 1.0),
        "c": nrm(ks[1], (BATCH, D_MODEL), 1.0),
        "ctx": nrm(ks[2], (BATCH, CTX_LEN, D_MODEL), 1.0),
        "c_ctx": nrm(ks[3], (D_MODEL,), 1.0),
        "w_mod": nrm(ks[4], (DEPTH, D_MODEL, N_MOD * D_MODEL), D_MODEL ** -0.5),
        "b_mod": nrm(ks[5], (DEPTH, N_MOD * D_MODEL), 0.02),
        "ln_g": 1.0 + nrm(ks[6], (DEPTH, 3, D_MODEL), 0.02),
        "ln_b": nrm(ks[7], (DEPTH, 3, D_MODEL), 0.02),
        "ffn_w_in": nrm(ks[8], (DEPTH, 2, D_MODEL, 2 * D_FF), D_MODEL ** -0.5),
        "ffn_w_out": nrm(ks[9], (DEPTH, 2, D_FF, D_MODEL), BETA * D_FF ** -0.5),
        "gmlp_w_in": nrm(ks[10], (N_A, D_MODEL, GMLP_D_FF), D_MODEL ** -0.5),
        "gmlp_ln_g": 1.0 + nrm(ks[11], (N_A, GMLP_HALF), 0.02),
        "gmlp_ln_b": nrm(ks[12], (N_A, GMLP_HALF), 0.02),
        "gmlp_w_s": nrm(ks[13], (N_A, GMLP_GROUPS, CHUNK, CHUNK), CHUNK ** -0.5),
        "gmlp_b_s": 1.0 + nrm(ks[14], (N_A, GMLP_GROUPS, CHUNK), 0.02),
        "gmlp_w_out": nrm(ks[15], (N_A, GMLP_HALF, D_MODEL), BETA * GMLP_HALF ** -0.5),
        "attn_w_qkv": nrm(ks[16], (N_B, D_MODEL, Q_DIM + 2 * KV_DIM), D_MODEL ** -0.5),
        "attn_q_norm": 1.0 + nrm(ks[17], (N_B, HEAD_DIM), 0.02),
        "attn_k_norm": 1.0 + nrm(ks[18], (N_B, HEAD_DIM), 0.02),
        "attn_w_o": nrm(ks[19], (N_B, Q_DIM, D_MODEL), BETA * Q_DIM ** -0.5),
    }


def reference(x, c, ctx, c_ctx, w_mod, b_mod, ln_g, ln_b, ffn_w_in, ffn_w_out,
              gmlp_w_in, gmlp_ln_g, gmlp_ln_b, gmlp_w_s, gmlp_b_s, gmlp_w_out,
              attn_w_qkv, attn_q_norm, attn_k_norm, attn_w_o):
    n_tok = x.shape[1]
    ROWS = n_tok // GRID_W
    rows = jnp.repeat(jnp.arange(ROWS, dtype=jnp.int32), GRID_W)
    cols = jnp.tile(jnp.arange(GRID_W, dtype=jnp.int32), ROWS)
    cos, sin = rope_tables(rows, cols)

    x_lat, x_ctx = x, ctx
    for i in range(DEPTH):
        is_attn = (i % N_MIXERS) == 1
        j = i // N_MIXERS
        last = i == DEPTH - 1
        ctx_feeds_mixer = (not last) or is_attn
        m_lat = modulation(c, w_mod[i], b_mod[i])
        m_ctx = modulation(c_ctx, w_mod[i], b_mod[i])

        x_lat = ffn_sublayer(x_lat, m_lat[0], m_lat[1], m_lat[2],
                             ffn_w_in[i, 0], ffn_w_out[i, 0], ln_g[i, 0], ln_b[i, 0])
        if ctx_feeds_mixer:
            x_ctx = ffn_sublayer(x_ctx, m_ctx[0], m_ctx[1], m_ctx[2],
                                 ffn_w_in[i, 0], ffn_w_out[i, 0], ln_g[i, 0], ln_b[i, 0])

        h_lat = modulate(x_lat, m_lat[3], m_lat[4])
        if is_attn:
            h_ctx = modulate(x_ctx, m_ctx[3], m_ctx[4])
            y_lat, y_ctx = gqa_mix(h_lat, h_ctx, attn_w_qkv[j], attn_q_norm[j], attn_k_norm[j],
                                   attn_w_o[j], cos, sin, not last)
        else:
            y_lat = gmlp_mix(h_lat, gmlp_w_in[j], gmlp_ln_g[j], gmlp_ln_b[j],
                             gmlp_w_s[j], gmlp_b_s[j], gmlp_w_out[j])
            y_ctx = None
            if not last:
                h_ctx = modulate(x_ctx, m_ctx[3], m_ctx[4])
                y_ctx = gmlp_mix(h_ctx, gmlp_w_in[j], gmlp_ln_g[j], gmlp_ln_b[j],
                                 gmlp_w_s[j], gmlp_b_s[j], gmlp_w_out[j])
        x_lat = layer_norm(ALPHA * x_lat + m_lat[5] * y_lat, ln_g[i, 1], ln_b[i, 1])
        if not last:
            x_ctx = layer_norm(ALPHA * x_ctx + m_ctx[5] * y_ctx, ln_g[i, 1], ln_b[i, 1])

        x_lat = ffn_sublayer(x_lat, m_lat[6], m_lat[7], m_lat[8],
                             ffn_w_in[i, 1], ffn_w_out[i, 1], ln_g[i, 2], ln_b[i, 2])
        if not last:
            x_ctx = ffn_sublayer(x_ctx, m_ctx[6], m_ctx[7], m_ctx[8],
                                 ffn_w_in[i, 1], ffn_w_out[i, 1], ln_g[i, 2], ln_b[i, 2])
    return x_lat
```

```cpp
#include <hip/hip_runtime.h>
#include <hip/hip_cooperative_groups.h>
#include <hip/hip_bf16.h>
#include <cstdio>
#include <cstdint>
namespace cg = cooperative_groups;
__device__ __forceinline__ int opaque_tid() { int t = threadIdx.x; asm volatile("" : "+v"(t)); return t; }
constexpr int DM = 1024, NLAT = 32768, SEQL = 16384, NCTXR = 512, CTXL = 256, MTOT = 33280;
constexpr int NPAN = 130, NPAN_LAT = 128;
constexpr int DFF = 2816, GH = 3072, NMOD = 9216, QKVN = 1536, KVROWS = 16640;
constexpr float ALPHA_C = 1.4142135623730951f;
constexpr float LN_EPS_C = 1e-5f, RMS_EPS_C = 1e-6f;
constexpr int GIN_PAN0 = 130;
constexpr int VT_CHUNKS = 132, VT_COLS = VT_CHUNKS * 128;
namespace pg8 {
#define PG8_LAS __attribute__((address_space(3)))
typedef unsigned short bf16_t;
typedef short bf16x8 __attribute__((ext_vector_type(8)));
typedef float f32x4 __attribute__((ext_vector_type(4)));
typedef unsigned u32x4 __attribute__((ext_vector_type(4)));
constexpr int BM = 256, BK = 64, HALF = 128, HTB = HALF * BK * 2  , STAGE_BYTES = 8 * HTB, NXCD = 8, WGM = 8;

__host__ __device__ __forceinline__ int lds_byte(int r, int c) { const int st = (r >> 4) * 2 + (c >> 5), rr = r & 15, cc = c & 31, ob = rr * 64 + cc * 2; return st * 1024 + (ob ^ (((ob >> 9) & 1) << 5)); }
__host__ __device__ __forceinline__ void stage_rc(int b, int& R, int& C) { const int st = b / 1024, sb = b % 1024, swz = sb ^ (((sb >> 9) & 1) << 5); R = (st >> 1) * 16 + swz / 64; C = (st & 1) * 32 + (swz % 64) / 2; }
__host__ __device__ __forceinline__ int perm32(int rho) { const int n = rho >> 4, i = rho & 15; return 8 * (i >> 2) + 4 * n + (i & 3); }

struct Unit { int pm, pn, kt0, nkt; };
struct Gemm { const bf16_t* A; const bf16_t* Bt; int M, N, K; };

struct StaticOrder {
    int nM, nN, nwg, G, c;
    __host__ __device__ void init(int M, int N, int G_, int c_) { nM = M / BM; nN = N / BM; nwg = nM * nN; G = G_; c = c_; }
    __host__ __device__ bool next(int i, Unit& u) const {
        const long L = (long)i * G + c; if (L >= nwg) return false;
        int wgid = (int)L; { const int q = nwg / NXCD, r = nwg % NXCD, xcd = wgid % NXCD, off = wgid / NXCD; wgid = (xcd < r ? xcd * (q + 1) : r * (q + 1) + (xcd - r) * q) + off; }
        const int nig = WGM * nN, gid = wgid / nig, fm = gid * WGM, gsz = (nM - fm) < WGM ? (nM - fm) : WGM;
        u.pm = fm + ((wgid % nig) % gsz); u.pn = (wgid % nig) / gsz; return true;
    }
    __device__ __forceinline__ void a_ready(const Unit&) const {}
    __device__ __forceinline__ void done(const Unit&) const {}
};

__device__ __forceinline__ unsigned cvt_pk_bf16(float lo, float hi) { unsigned r; asm volatile("v_cvt_pk_bf16_f32 %0, %1, %2" : "=v"(r) : "v"(lo), "v"(hi)); return r; }
typedef float f32x2 __attribute__((ext_vector_type(2)));
__device__ __forceinline__ f32x2 gelu_pk(f32x2 v) {
    const f32x2 av = __builtin_elementwise_abs(v), d = av * 0.2316418882f + 1.0f;
    f32x2 t; t.x = __builtin_amdgcn_rcpf(d.x); t.y = __builtin_amdgcn_rcpf(d.y);
    f32x2 q = t * 0.5307027145f + (-0.7265760135f); q = q * t + 0.7107068705f; q = q * t + (-0.142248368f); q = q * t + 0.127414796f; q = q * t;
    const f32x2 s = (v * v) * (-0.72134752044f);
    f32x2 e; e.x = __builtin_amdgcn_exp2f(s.x); e.y = __builtin_amdgcn_exp2f(s.y);
    const f32x2 m = v * (q * e), r = v - m;
    f32x2 o; o.x = v.x < 0.f ? m.x : r.x; o.y = v.y < 0.f ? m.y : r.y; return o;
}
typedef unsigned u32x2 __attribute__((ext_vector_type(2)));
__device__ __forceinline__ float silu_f(float g) { return g * __builtin_amdgcn_rcpf(1.0f + __builtin_amdgcn_exp2f(-1.4426950408889634f * g)); }
struct EpiSwiglu {
    static constexpr bool PERM = true, AFTER_DRAIN = false;
    bf16_t* H;
    __device__ __forceinline__ void operator()(const f32x4 (&acc)[2][2][4][2], const Unit& u, int wr, int wc, int fr, int fq) const {
        const int row0 = u.pm * BM + wr * 64 + fr, col0 = u.pn * HALF + wc * 32 + 8 * fq;
#pragma unroll
        for (int ai = 0; ai < 2; ++ai)
#pragma unroll
            for (int m = 0; m < 4; ++m) { bf16_t* rowp = H + (size_t)(row0 + ai * HALF + m * 16) * DFF + col0;
                const f32x4 g0 = acc[ai][0][m][0], g1 = acc[ai][0][m][1], u0 = acc[ai][1][m][0], u1 = acc[ai][1][m][1];
                u32x4 w; w.x = cvt_pk_bf16(silu_f(g0[0]) * u0[0], silu_f(g0[1]) * u0[1]); w.y = cvt_pk_bf16(silu_f(g0[2]) * u0[2], silu_f(g0[3]) * u0[3]);
                w.z = cvt_pk_bf16(silu_f(g1[0]) * u1[0], silu_f(g1[1]) * u1[1]); w.w = cvt_pk_bf16(silu_f(g1[2]) * u1[2], silu_f(g1[3]) * u1[3]);
                *(u32x4*)rowp = w; }
    }
};
struct EpiResid {
    static constexpr bool PERM = false, AFTER_DRAIN = false;
    const float* res_lat; const float* res_ctx; float* dst_lat; float* dst_ctx; const float* gate; float gs; float* cpart;
    const float* stats; const float* lng; const float* lnb;
    __device__ __forceinline__ void operator()(const f32x4 (&acc)[2][2][4][2], const Unit& u, int wr, int wc, int fr, int fq) const {
        const bool isctx = u.pm >= NPAN_LAT; const int cond = u.pm < 64 ? 0 : (u.pm < 128 ? 1 : 2);
        const bool raw = isctx && cpart != nullptr;
        const char* rb = (const char*)(isctx ? res_ctx + (size_t)(u.pm - NPAN_LAT) * BM * DM : res_lat + (size_t)u.pm * BM * DM) + (size_t)u.pn * BM * 4;
        char* db = (char*)(raw ? cpart + (size_t)(u.kt0 >> 2) * NCTXR * DM + (size_t)(u.pm - NPAN_LAT) * BM * DM : (isctx ? dst_ctx + (size_t)(u.pm - NPAN_LAT) * BM * DM : dst_lat + (size_t)u.pm * BM * DM)) + (size_t)u.pn * BM * 4;
        const char* gp = (const char*)(gate + cond * NMOD + u.pn * BM);
        const char* lgp = (const char*)(lng + u.pn * BM); const char* lbp = (const char*)(lnb + u.pn * BM);
        const char* stp = (const char*)(stats + (size_t)u.pm * BM * 2);
        unsigned cofs = (unsigned)(wc * 32 + 4 * fq) * 4u;
        unsigned rofs = (unsigned)(wr * 64 + fr);
        asm volatile("" : "+v"(cofs), "+v"(rofs));
        if (raw) {
#pragma unroll
            for (int ai = 0; ai < 2; ++ai)
#pragma unroll
                for (int m = 0; m < 4; ++m) { const unsigned off = (rofs + ai * HALF + m * 16) * (DM * 4u) + cofs;
#pragma unroll
                    for (int bj = 0; bj < 2; ++bj)
#pragma unroll
                        for (int n = 0; n < 2; ++n) *(f32x4*)(db + off + (bj * HALF + n * 16) * 4) = acc[ai][bj][m][n]; }
        } else if (stats != nullptr && !isctx) {
#pragma unroll
            for (int ai = 0; ai < 2; ++ai)
#pragma unroll
                for (int m = 0; m < 4; ++m) { const unsigned rr = rofs + ai * HALF + m * 16, off = rr * (DM * 4u) + cofs;
                    const f32x2 st = *(const f32x2*)(stp + rr * 8u); const float a = st.y * ALPHA_C, b = -st.x * a;
#pragma unroll
                    for (int bj = 0; bj < 2; ++bj)
#pragma unroll
                        for (int n = 0; n < 2; ++n) { const unsigned co = (bj * HALF + n * 16) * 4u;
                            const f32x4 z = *(const f32x4*)(rb + off + co), gv = *(const f32x4*)(gp + cofs + co), lg = *(const f32x4*)(lgp + cofs + co), lb = *(const f32x4*)(lbp + cofs + co);
                            *(f32x4*)(db + off + co) = (z * a + b) * lg + lb * ALPHA_C + gv * gs * acc[ai][bj][m][n]; }
                    asm volatile("" ::: "memory"); }
        } else {
#pragma unroll
            for (int ai = 0; ai < 2; ++ai)
#pragma unroll
                for (int m = 0; m < 4; ++m) { const unsigned off = (rofs + ai * HALF + m * 16) * (DM * 4u) + cofs;
#pragma unroll
                    for (int bj = 0; bj < 2; ++bj)
#pragma unroll
                        for (int n = 0; n < 2; ++n) { const unsigned co = (bj * HALF + n * 16) * 4u; const f32x4 r = *(const f32x4*)(rb + off + co), gv = *(const f32x4*)(gp + cofs + co);
                            *(f32x4*)(db + off + co) = r * ALPHA_C + gv * gs * acc[ai][bj][m][n]; }
                    asm volatile("" ::: "memory"); }
        }
    }
};

struct EpiGmlp {
    static constexpr bool PERM = true, AFTER_DRAIN = false;
    bf16_t* U; bf16_t* VT; float* part; int p0;
    __device__ __forceinline__ void operator()(const f32x4 (&acc)[2][2][4][2], const Unit& u, int wr, int wc, int fr, int fq) const {
        if (u.pm < NPAN) {
            const int row0 = u.pm * BM + wr * 64 + fr, col0 = (u.pn - GIN_PAN0) * BM + wc * 32 + 8 * fq;
#pragma unroll
            for (int ai = 0; ai < 2; ++ai)
#pragma unroll
                for (int m = 0; m < 4; ++m) { bf16_t* rowp = U + (size_t)(row0 + ai * HALF + m * 16) * GH + col0;
#pragma unroll
                    for (int bj = 0; bj < 2; ++bj) { const f32x4 v0 = acc[ai][bj][m][0], v1 = acc[ai][bj][m][1];
                        const f32x2 a = gelu_pk((f32x2){v0[0], v0[1]}), b = gelu_pk((f32x2){v0[2], v0[3]}), c = gelu_pk((f32x2){v1[0], v1[1]}), d = gelu_pk((f32x2){v1[2], v1[3]});
                        u32x4 w; w.x = cvt_pk_bf16(a.x, a.y); w.y = cvt_pk_bf16(b.x, b.y); w.z = cvt_pk_bf16(c.x, c.y); w.w = cvt_pk_bf16(d.x, d.y);
                        *(u32x4*)(rowp + bj * HALF) = w; asm volatile("" ::: "memory"); } }
        } else {
            const int ct = u.pm - (GIN_PAN0 + 12);
            const int crow0 = ct * BM + wr * 64 + fr;
            const int lane = fr + 16 * fq;
#pragma unroll
            for (int bj = 0; bj < 2; ++bj) {
                const int chunk = (u.pn - p0) * 2 + bj; const int q0 = wc * 32 + 8 * fq;
                float s[8], q[8];
#pragma unroll
                for (int j = 0; j < 8; ++j) { s[j] = 0.f; q[j] = 0.f; }
#pragma unroll
                for (int ai = 0; ai < 2; ++ai)
#pragma unroll
                    for (int m = 0; m < 4; ++m) { const f32x4 v0 = acc[ai][bj][m][0], v1 = acc[ai][bj][m][1];
                        const f32x2 a = gelu_pk((f32x2){v0[0], v0[1]}), b = gelu_pk((f32x2){v0[2], v0[3]}), c = gelu_pk((f32x2){v1[0], v1[1]}), d = gelu_pk((f32x2){v1[2], v1[3]});
                        s[0] += a.x; s[1] += a.y; s[2] += b.x; s[3] += b.y; s[4] += c.x; s[5] += c.y; s[6] += d.x; s[7] += d.y;
                        q[0] += a.x * a.x; q[1] += a.y * a.y; q[2] += b.x * b.x; q[3] += b.y * b.y; q[4] += c.x * c.x; q[5] += c.y * c.y; q[6] += d.x * d.x; q[7] += d.y * d.y;
                        u32x4 w; w.x = cvt_pk_bf16(a.x, a.y); w.y = cvt_pk_bf16(b.x, b.y); w.z = cvt_pk_bf16(c.x, c.y); w.w = cvt_pk_bf16(d.x, d.y);
                        *(u32x4*)(VT + ((size_t)chunk * GH + crow0 + ai * HALF + m * 16) * 128 + q0) = w;
                        asm volatile("" : "+v"(s[0]), "+v"(s[1]), "+v"(s[2]), "+v"(s[3]), "+v"(s[4]), "+v"(s[5]), "+v"(s[6]), "+v"(s[7]));
                        asm volatile("" : "+v"(q[0]), "+v"(q[1]), "+v"(q[2]), "+v"(q[3]), "+v"(q[4]), "+v"(q[5]), "+v"(q[6]), "+v"(q[7]) :: "memory"); }
#pragma unroll
                for (int j = 0; j < 8; ++j) {
#pragma unroll
                    for (int o = 1; o < 16; o <<= 1) { s[j] += __shfl_xor(s[j], o); q[j] += __shfl_xor(q[j], o); } }
                if (fr == 0) { float* pp = part + ((size_t)(ct * 2 + wr) * VT_COLS + chunk * 128 + q0) * 2;
#pragma unroll
                    for (int j = 0; j < 8; j += 2) *(f32x4*)(pp + 2 * j) = (f32x4){s[j], q[j], s[j + 1], q[j + 1]}; }
            }
            (void)lane;
        }
    }
};
struct EpiQKV {
    static constexpr bool PERM = true, AFTER_DRAIN = false;
    bf16_t* Q; bf16_t* KB; bf16_t* VB;
    __device__ __forceinline__ void operator()(const f32x4 (&acc)[2][2][4][2], const Unit& u, int wr, int wc, int fr, int fq) const {
        bf16_t* base; int ldc;
        if (u.pn < 4) { base = Q + (size_t)u.pm * BM * DM + u.pn * BM; ldc = DM; }
        else { const int kvrow0 = u.pm < 64 ? CTXL + u.pm * BM : (u.pm < 128 ? KVROWS + CTXL + (u.pm - 64) * BM : (u.pm - 128) * KVROWS);
               base = (u.pn == 4 ? KB : VB) + (size_t)kvrow0 * 256; ldc = 256; }
        base += (size_t)(wr * 64 + fr) * ldc + wc * 32 + 8 * fq;
#pragma unroll
        for (int ai = 0; ai < 2; ++ai)
#pragma unroll
            for (int m = 0; m < 4; ++m) { bf16_t* rowp = base + (size_t)(ai * HALF + m * 16) * ldc;
#pragma unroll
                for (int bj = 0; bj < 2; ++bj) { const f32x4 v0 = acc[ai][bj][m][0], v1 = acc[ai][bj][m][1];
                    u32x4 w; w.x = cvt_pk_bf16(v0[0], v0[1]); w.y = cvt_pk_bf16(v0[2], v0[3]); w.z = cvt_pk_bf16(v1[0], v1[1]); w.w = cvt_pk_bf16(v1[2], v1[3]);
                    *(u32x4*)(rowp + bj * HALF) = w; } }
    }
};
struct GmlpOrder {
    StaticOrder so; int p0;
    __device__ void init(int p0_, int np, int G, int c) { p0 = p0_; so.init(np * BM, 24 * BM, G, c); }
    __device__ bool next(int i, Unit& u) const { Unit v; if (!so.next(i, v)) return false;
        if (v.pn < 12) { u.pm = p0 + v.pm; u.pn = GIN_PAN0 + v.pn; } else { u.pm = GIN_PAN0 + v.pn; u.pn = p0 + v.pm; } return true; }
    __device__ __forceinline__ void a_ready(const Unit&) const {}
    __device__ __forceinline__ void done(const Unit&) const {}
};
struct ResidOrder {
    StaticOrder so; int ns, nkf;
    __device__ __forceinline__ void init(int ns_, int nkt_full, int G_, int c_) { ns = ns_; nkf = nkt_full; so.init(NPAN_LAT * BM, 4 * BM, G_, c_); }
    __device__ __forceinline__ bool next(int i, Unit& u) const {
        const int L = i * so.G + so.c; Unit v; v.pm = 0; v.pn = 0;
        const bool lat = so.next(i, v);
        const int e = L - 512, tile = e / (ns > 0 ? ns : 1), sl = e - tile * ns;
        const bool ok = lat || (e >= 0 && e < 8 * ns);
        u.pm = lat ? v.pm : 128 + (tile >> 2); u.pn = lat ? v.pn : (tile & 3); u.kt0 = lat ? 0 : 4 * sl; u.nkt = lat ? nkf : 4;
        return ok; }
    __device__ __forceinline__ void a_ready(const Unit&) const {}
    __device__ __forceinline__ void done(const Unit&) const {}
};
struct QkvOrder {
    StaticOrder so; int G, c;
    __device__ void init(int G_, int c_) { G = G_; c = c_; so.init(NPAN_LAT * BM, 6 * BM, G_, c_); }
    __device__ bool next(int i, Unit& u) const { const int L = i * G + c; if (L < 768) return so.next(i, u); if (L >= 772) return false;
        const int e = L - 768; u.pm = 128 + (e >> 1); u.pn = 4 + (e & 1); return true; }
    __device__ __forceinline__ void a_ready(const Unit&) const {}
    __device__ __forceinline__ void done(const Unit&) const {}
};
template <class Epi, class Sched, bool ALIGN_EPI = false, bool SP2 = false>
__device__ __forceinline__ void gemm_phase(PG8_LAS unsigned char* lds, const Gemm g, const Sched& S, const Epi& E) {
    const int tid = opaque_tid(), wid = __builtin_amdgcn_readfirstlane(tid >> 6), lane = tid & 63, wr = wid >> 2, wc = wid & 3, fr = lane & 15, fq = lane >> 4;
    const int K = g.K;
    unsigned voffA[2], voffB[2];
#pragma unroll
    for (int i = 0; i < 2; ++i) { int R, C; stage_rc(tid * 16 + i * 8192, R, C); const int Rb = Epi::PERM ? ((R & ~31) + perm32(R & 31)) : R;
        voffA[i] = (unsigned)(R * K + C) * 2u; voffB[i] = (unsigned)(Rb * K + C) * 2u; }
    const size_t kstep = (size_t)(BK * 2);
    const size_t hstep = (size_t)HALF * K * 2;
    const size_t tstep = 2 * hstep;
    const unsigned ldsw = (unsigned)wid * 1024u;
    const int aoff = lds_byte(wr * 64 + fr, fq * 8), boff = lds_byte(wc * 32 + fr, fq * 8);
#define PG8_SA(b, h) (((b) * 2 + (h)) * HTB)
#define PG8_SB(b, h) ((4 + (b) * 2 + (h)) * HTB)
#define PG8_STAGE(bufoff, gbase, voff) do { _Pragma("unroll") for (int _i = 0; _i < 2; ++_i) \
        __builtin_amdgcn_global_load_lds((const unsigned*)((const char*)(gbase) + (voff)[_i]), (PG8_LAS unsigned*)(lds + (bufoff) + ldsw + _i * 8192), 16, 0, 0); } while (0)
#define PG8_LDA(dst, b, h) do { _Pragma("unroll") for (int m = 0; m < 4; ++m) _Pragma("unroll") for (int k = 0; k < 2; ++k) dst[m][k] = *(const PG8_LAS bf16x8*)(lds + PG8_SA(b, h) + aoff + m * 2048 + k * 1024); } while (0)
#define PG8_LDB(dst, b, h) do { _Pragma("unroll") for (int n = 0; n < 2; ++n) _Pragma("unroll") for (int k = 0; k < 2; ++k) dst[n][k] = *(const PG8_LAS bf16x8*)(lds + PG8_SB(b, h) + boff + n * 2048 + k * 1024); } while (0)
#define PG8_MMA(ai, bj, At, Bt) do { __builtin_amdgcn_s_setprio(1); _Pragma("unroll") for (int m = 0; m < 4; ++m) _Pragma("unroll") for (int n = 0; n < 2; ++n) _Pragma("unroll") for (int k = 0; k < 2; ++k) \
        acc[ai][bj][m][n] = __builtin_amdgcn_mfma_f32_16x16x32_bf16(Bt[n][k], At[m][k], acc[ai][bj][m][n], 0, 0, 0); __builtin_amdgcn_s_setprio(0); } while (0)
#define PG8_WAIT_V(n) asm volatile("s_waitcnt vmcnt(" #n ")" ::: "memory")
#define PG8_WAIT_L(n) asm volatile("s_waitcnt lgkmcnt(" #n ")" ::: "memory")
#define PG8_BAR __builtin_amdgcn_s_barrier()
#define PG8_SCHED __builtin_amdgcn_sched_barrier(0)
    Unit cur, nxt; int ui = 0;
    cur.kt0 = 0; cur.nkt = K / BK;
    if (!S.next(0, cur)) return;
    f32x4 acc[2][2][4][2];
#pragma unroll
    for (int a = 0; a < 2; ++a)
#pragma unroll
        for (int b = 0; b < 2; ++b)
#pragma unroll
            for (int m = 0; m < 4; ++m)
#pragma unroll
                for (int n = 0; n < 2; ++n) acc[a][b][m][n] = (f32x4){0.f, 0.f, 0.f, 0.f};
    bf16x8 At[4][2], B0[2][2], B1[2][2];
    const char* cA = (const char*)g.A + (size_t)cur.pm * tstep + (size_t)cur.kt0 * kstep; const char* cB = (const char*)g.Bt + (size_t)cur.pn * tstep + (size_t)cur.kt0 * kstep;
    S.a_ready(cur);
    if constexpr (SP2) {
        PG8_STAGE(PG8_SB(0, 0), cB, voffB); PG8_STAGE(PG8_SB(0, 1), cB + hstep, voffB); PG8_STAGE(PG8_SA(0, 0), cA, voffA); PG8_STAGE(PG8_SA(0, 1), cA + hstep, voffA);
        if (wr == 1) PG8_BAR;
        PG8_WAIT_V(2); PG8_BAR;
        PG8_STAGE(PG8_SB(1, 0), cB + kstep, voffB); PG8_STAGE(PG8_SA(1, 0), cA + kstep, voffA); PG8_STAGE(PG8_SB(1, 1), cB + hstep + kstep, voffB);
        PG8_WAIT_V(6); PG8_BAR;
    } else {
        PG8_STAGE(PG8_SB(0, 0), cB, voffB); PG8_STAGE(PG8_SA(0, 0), cA, voffA); PG8_STAGE(PG8_SB(0, 1), cB + hstep, voffB); PG8_STAGE(PG8_SA(0, 1), cA + hstep, voffA);
        if (wr == 1) PG8_BAR;
        PG8_WAIT_V(4); PG8_BAR;
        PG8_STAGE(PG8_SB(1, 0), cB + kstep, voffB); PG8_STAGE(PG8_SA(1, 0), cA + kstep, voffA); PG8_STAGE(PG8_SB(1, 1), cB + hstep + kstep, voffB);
        PG8_WAIT_V(6); PG8_BAR;
    }
    for (;;) {
        nxt.kt0 = 0; nxt.nkt = K / BK;
        const bool has_next = S.next(ui + 1, nxt);
        const int nt = cur.nkt;
        const char* nA = has_next ? (const char*)g.A + (size_t)nxt.pm * tstep + (size_t)nxt.kt0 * kstep : cA; const char* nB = has_next ? (const char*)g.Bt + (size_t)nxt.pn * tstep + (size_t)nxt.kt0 * kstep : cB;
        for (int t = 0; t < nt; t += 2) {
            const bool last = (t == nt - 2);
            const char* a1 = cA + (size_t)(t + 1) * kstep;
            const char* a2 = last ? nA : cA + (size_t)(t + 2) * kstep; const char* b2 = last ? nB : cB + (size_t)(t + 2) * kstep;
            const char* a3 = a2 + kstep; const char* b3 = b2 + kstep;
            if (last && has_next) S.a_ready(nxt);
            if constexpr (SP2) {
            PG8_LDB(B0, 0, 0); PG8_LDB(B1, 0, 1); PG8_SCHED; PG8_LDA(At, 0, 0); PG8_STAGE(PG8_SA(1, 1), a1 + hstep, voffA);
            PG8_WAIT_V(8); PG8_WAIT_L(0); PG8_BAR; PG8_MMA(0, 0, At, B0); PG8_MMA(0, 1, At, B1); PG8_BAR; PG8_SCHED;
            PG8_LDA(At, 0, 1); PG8_STAGE(PG8_SB(0, 0), b2, voffB); PG8_STAGE(PG8_SB(0, 1), b2 + hstep, voffB); PG8_STAGE(PG8_SA(0, 0), a2, voffA);
            PG8_WAIT_V(8); PG8_WAIT_L(0); PG8_BAR; PG8_MMA(1, 0, At, B0); PG8_MMA(1, 1, At, B1); PG8_BAR; PG8_SCHED;
            PG8_LDB(B0, 1, 0); PG8_LDB(B1, 1, 1); PG8_SCHED; PG8_LDA(At, 1, 0); PG8_STAGE(PG8_SA(0, 1), a2 + hstep, voffA);
            PG8_WAIT_V(8); PG8_WAIT_L(0); PG8_BAR; PG8_MMA(0, 0, At, B0); PG8_MMA(0, 1, At, B1); PG8_BAR; PG8_SCHED;
            PG8_LDA(At, 1, 1); PG8_STAGE(PG8_SB(1, 0), b3, voffB); PG8_STAGE(PG8_SB(1, 1), b3 + hstep, voffB); PG8_STAGE(PG8_SA(1, 0), a3, voffA);
            PG8_WAIT_V(8); PG8_WAIT_L(0); PG8_BAR; PG8_MMA(1, 0, At, B0); PG8_MMA(1, 1, At, B1); PG8_BAR; PG8_SCHED;
            } else {
            PG8_LDB(B0, 0, 0); PG8_SCHED; PG8_LDA(At, 0, 0); PG8_STAGE(PG8_SA(1, 1), a1 + hstep, voffA);
            PG8_WAIT_L(8); PG8_BAR; PG8_WAIT_L(0); PG8_MMA(0, 0, At, B0); PG8_BAR; PG8_SCHED;
            PG8_LDB(B1, 0, 1); PG8_STAGE(PG8_SB(0, 0), b2, voffB);
            PG8_BAR; PG8_WAIT_L(0); PG8_MMA(0, 1, At, B1); PG8_BAR;
            PG8_LDA(At, 0, 1); PG8_STAGE(PG8_SA(0, 0), a2, voffA);
            PG8_BAR; PG8_WAIT_L(0); PG8_MMA(1, 0, At, B0); PG8_BAR; PG8_SCHED;
            PG8_STAGE(PG8_SB(0, 1), b2 + hstep, voffB);
            PG8_WAIT_V(6); PG8_BAR; PG8_MMA(1, 1, At, B1); PG8_BAR;
            PG8_LDB(B0, 1, 0); PG8_SCHED; PG8_LDA(At, 1, 0); PG8_STAGE(PG8_SA(0, 1), a2 + hstep, voffA);
            PG8_WAIT_L(8); PG8_BAR; PG8_WAIT_L(0); PG8_MMA(0, 0, At, B0); PG8_BAR; PG8_SCHED;
            PG8_LDB(B1, 1, 1); PG8_STAGE(PG8_SB(1, 0), b3, voffB);
            PG8_BAR; PG8_WAIT_L(0); PG8_MMA(0, 1, At, B1); PG8_BAR;
            PG8_LDA(At, 1, 1); PG8_STAGE(PG8_SA(1, 0), a3, voffA);
            PG8_BAR; PG8_WAIT_L(0); PG8_MMA(1, 0, At, B0); PG8_BAR; PG8_SCHED;
            PG8_STAGE(PG8_SB(1, 1), b3 + hstep, voffB);
            PG8_WAIT_V(6); PG8_BAR; PG8_MMA(1, 1, At, B1); PG8_BAR;
            }
        }
        if constexpr (ALIGN_EPI) { if (wr == 0) PG8_BAR; }
        if constexpr (!Epi::AFTER_DRAIN) { E(acc, cur, wr, wc, fr, fq); S.done(cur); }
        if (!has_next) break;
#pragma unroll
        for (int a = 0; a < 2; ++a)
#pragma unroll
            for (int b = 0; b < 2; ++b)
#pragma unroll
                for (int m = 0; m < 4; ++m)
#pragma unroll
                    for (int n = 0; n < 2; ++n) acc[a][b][m][n] = (f32x4){0.f, 0.f, 0.f, 0.f};
        cur = nxt; cA = nA; cB = nB; ++ui;
        if constexpr (ALIGN_EPI) { if (wr == 1) PG8_BAR; }
    }
    PG8_WAIT_V(0);
    if constexpr (!ALIGN_EPI) { if (wr == 0) PG8_BAR; }
    PG8_BAR;
    if constexpr (Epi::AFTER_DRAIN) { E.fused(acc, cur, wr, wc, fr, fq, lds, wid, lane); S.done(cur); }
#undef PG8_SA
#undef PG8_SB
#undef PG8_STAGE
#undef PG8_LDA
#undef PG8_LDB
#undef PG8_MMA
#undef PG8_WAIT_V
#undef PG8_WAIT_L
#undef PG8_BAR
#undef PG8_SCHED
}
}
namespace att {
using bf16 = __hip_bfloat16;
constexpr int D = 128, NW = 8, QBLK = 32, KVBLK = 64;
constexpr float SCALE = 0.088388347648318440f;
constexpr float THR = 8.f;
constexpr int SDEPTH = 2;
constexpr int LDQ = 1024, LDK = 256, LDO = 1024;
constexpr size_t SHM_V = KVBLK * D * 2, SHM_K = KVBLK * D * 2, SHM_ATTN = 2 * SHM_V + 2 * SHM_K + NW * 64 * 4;
using bf16x8 = __attribute__((ext_vector_type(8))) short;
using s16x4  = __attribute__((ext_vector_type(4))) short;
using f32x16 = __attribute__((ext_vector_type(16))) float;
using f32x8  = __attribute__((ext_vector_type(8))) float;
using u32x4  = __attribute__((ext_vector_type(4))) unsigned;
#define KSWZ(row, colB) ((row) * 256 + ((colB) ^ (((row) & 7) << 4)))
#define SBAR() __builtin_amdgcn_sched_barrier(0)
__device__ __forceinline__ int crow(int r, int hi) { return (r & 3) + 8 * (r >> 2) + 4 * hi; }
__device__ __forceinline__ unsigned cvtpk(float lo, float hi) {
  unsigned r; asm volatile("v_cvt_pk_bf16_f32 %0, %1, %2" : "=v"(r) : "v"(lo), "v"(hi)); return r;
}
template <typename TIn> struct Stage;
template <> struct Stage<bf16>  { using T = bf16x8;
  __device__ static __forceinline__ T ld8(const bf16* p) { return *reinterpret_cast<const bf16x8*>(p); }
  __device__ static __forceinline__ bf16x8 tobf(T x) { return x; } };
template <> struct Stage<float> { using T = f32x8;
  __device__ static __forceinline__ T ld8(const float* p) { return *reinterpret_cast<const f32x8*>(p); }
  __device__ static __forceinline__ bf16x8 tobf(T x) {
    u32x4 w = {cvtpk(x[0], x[1]), cvtpk(x[2], x[3]), cvtpk(x[4], x[5]), cvtpk(x[6], x[7])}; return *reinterpret_cast<bf16x8*>(&w); } };

__device__ __forceinline__ void partialSM(f32x16& p0, f32x16& p1, float& m_reg, float& mn, float& alpha) {
  constexpr float C = SCALE * 1.4426950408889634f;
  float pmax = p0[0]; for (int r = 1; r < 16; ++r) pmax = fmaxf(pmax, p0[r]); for (int r = 0; r < 16; ++r) pmax = fmaxf(pmax, p1[r]);
  { auto rr = __builtin_amdgcn_permlane32_swap(__float_as_uint(pmax), __float_as_uint(pmax), false, false);
    pmax = fmaxf(__uint_as_float(rr[0]), __uint_as_float(rr[1])); }
  if (__builtin_expect(__all(pmax - m_reg <= THR / SCALE), 1)) { mn = m_reg; alpha = 1.f; }
  else { mn = fmaxf(m_reg, pmax); alpha = __builtin_amdgcn_exp2f((m_reg - mn) * C); m_reg = mn; }
  float mnC = -mn * C;
  for (int r = 0; r < 16; ++r) p0[r] = fmaf(p0[r], C, mnC); for (int r = 0; r < 16; ++r) p1[r] = fmaf(p1[r], C, mnC);
  for (int r = 0; r < 16; ++r) p0[r] = __builtin_amdgcn_exp2f(p0[r]);
}
__device__ __forceinline__ void finishSM(f32x16& p0, f32x16& p1, float alpha, float& l_reg, bf16x8& pa0, bf16x8& pa1, bf16x8& pa2, bf16x8& pa3) {
  for (int r = 0; r < 16; ++r) p1[r] = __builtin_amdgcn_exp2f(p1[r]);
  float ps = 0; for (int r = 0; r < 16; ++r) ps += p0[r]; for (int r = 0; r < 16; ++r) ps += p1[r];
  { auto rr = __builtin_amdgcn_permlane32_swap(__float_as_uint(ps), __float_as_uint(ps), false, false);
    ps = __uint_as_float(rr[0]) + __uint_as_float(rr[1]); }
  l_reg = l_reg * alpha + ps;
#define PK4(P, BASE, OUT) do { unsigned a0 = cvtpk(P[BASE + 0], P[BASE + 1]), a1 = cvtpk(P[BASE + 2], P[BASE + 3]);   \
    unsigned b0 = cvtpk(P[BASE + 4], P[BASE + 5]), b1 = cvtpk(P[BASE + 6], P[BASE + 7]);                              \
    auto r0 = __builtin_amdgcn_permlane32_swap(a0, b0, false, false); auto r1 = __builtin_amdgcn_permlane32_swap(a1, b1, false, false); \
    u32x4 w = {r0[0], r1[0], r0[1], r1[1]}; OUT = *reinterpret_cast<bf16x8*>(&w); } while (0)
  PK4(p0, 0, pa0); PK4(p0, 8, pa1); PK4(p1, 0, pa2); PK4(p1, 8, pa3);
#undef PK4
}
__device__ __forceinline__ void qkt(f32x16& p0, f32x16& p1, const bf16* Ks, const bf16x8* qr, int r32, int hi) {
  p0 = f32x16{}; p1 = f32x16{};
  for (int d0 = 0; d0 < 8; ++d0) { int cb = (d0 * 16 + hi * 8) * 2;
    bf16x8 b0 = *reinterpret_cast<const bf16x8*>((const char*)Ks + KSWZ(r32, cb));
    bf16x8 b1 = *reinterpret_cast<const bf16x8*>((const char*)Ks + KSWZ(32 + r32, cb));
    p0 = __builtin_amdgcn_mfma_f32_32x32x16_bf16(b0, qr[d0], p0, 0, 0, 0);
    p1 = __builtin_amdgcn_mfma_f32_32x32x16_bf16(b1, qr[d0], p1, 0, 0, 0); }
}
__device__ __forceinline__ int v_st(int k, int c) { const int kk = (k & ~0xC) | ((k & 4) << 1) | ((k & 8) >> 1); return ((kk >> 3) * 4 + (c >> 5)) * 512 + ((kk & 7) * 32 + (c & 31)) * 2; }
__device__ __forceinline__ int v_rd_base(int lane) { return ((lane & 3) << 3) | (((lane >> 2) & 3) << 6) | (((lane >> 4) & 1) << 5) | (((lane >> 5) & 1) << 8); }
constexpr int v_rd_off(int d0, int ks, int half) { return d0 * 512 + ks * 4096 + half * 2048; }
template <int OFF> __device__ __forceinline__ s16x4 tr_read(int vb) {
  s16x4 r; asm volatile("ds_read_b64_tr_b16 %0, %1 offset:%2" : "=&v"(r) : "v"(vb), "i"(OFF) : "memory"); return r;
}
template <int D0> __device__ __forceinline__ void pv_one(f32x16& od, int vb, bf16x8 pa0, bf16x8 pa1, bf16x8 pa2, bf16x8 pa3) {
  const s16x4 l0 = tr_read<v_rd_off(D0, 0, 0)>(vb), h0 = tr_read<v_rd_off(D0, 0, 1)>(vb), l1 = tr_read<v_rd_off(D0, 1, 0)>(vb), h1 = tr_read<v_rd_off(D0, 1, 1)>(vb);
  const s16x4 l2 = tr_read<v_rd_off(D0, 2, 0)>(vb), h2 = tr_read<v_rd_off(D0, 2, 1)>(vb), l3 = tr_read<v_rd_off(D0, 3, 0)>(vb), h3 = tr_read<v_rd_off(D0, 3, 1)>(vb);
  asm volatile("s_waitcnt lgkmcnt(0)" ::: "memory"); SBAR();
#define PK(L, H) (bf16x8){L[0], L[1], L[2], L[3], H[0], H[1], H[2], H[3]}
  od = __builtin_amdgcn_mfma_f32_32x32x16_bf16(pa0, PK(l0, h0), od, 0, 0, 0);
  od = __builtin_amdgcn_mfma_f32_32x32x16_bf16(pa1, PK(l1, h1), od, 0, 0, 0);
  od = __builtin_amdgcn_mfma_f32_32x32x16_bf16(pa2, PK(l2, h2), od, 0, 0, 0);
  od = __builtin_amdgcn_mfma_f32_32x32x16_bf16(pa3, PK(l3, h3), od, 0, 0, 0);
#undef PK
}
__device__ __forceinline__ void pv_d0(f32x16* o, int vb, bf16x8 pa0, bf16x8 pa1, bf16x8 pa2, bf16x8 pa3) {
  pv_one<0>(o[0], vb, pa0, pa1, pa2, pa3); pv_one<1>(o[1], vb, pa0, pa1, pa2, pa3); pv_one<2>(o[2], vb, pa0, pa1, pa2, pa3); pv_one<3>(o[3], vb, pa0, pa1, pa2, pa3);
}
__device__ __forceinline__ void attn_dense_body(const bf16* __restrict__ Qb, const bf16* __restrict__ Kh, const bf16* __restrict__ Vh,
                                                bf16* __restrict__ Ob, int seq, char* lds) {
  using St = Stage<bf16>;
  const int tid = opaque_tid(), wid = tid >> 6, lane = tid & 63, r32 = lane & 31, hi = lane >> 5;
  bf16* V_lds = (bf16*)lds; bf16* K_lds = (bf16*)(lds + 2 * SHM_V);
  float* ws = (float*)(lds + 2 * SHM_V + 2 * SHM_K) + wid * 64; float* li_l = ws; float* al_l = ws + 32;
  float m_reg = -1e30f, l_reg = 0; f32x16 o[4] = {}; bf16x8 qr[8];
  const bf16* Qw = Qb + (long)(wid * QBLK + r32) * LDQ + hi * 8;
#pragma unroll
  for (int d0 = 0; d0 < 8; ++d0) qr[d0] = St::ld8(Qw + d0 * 16);
  const int sr = tid >> 4, sc = (tid & 15) * 8, vst0 = v_st(sr, sc), vst1 = v_st(32 + sr, sc);
  const int vb0 = (int)(uintptr_t)V_lds + v_rd_base(lane);
  struct { typename St::T vs0, vs1, ks0, ks1; } sr_[SDEPTH];
#define SLOAD(i, k0) do { sr_[i].vs0 = St::ld8(&Vh[(long)((k0) + sr) * LDK + sc]); sr_[i].vs1 = St::ld8(&Vh[(long)((k0) + 32 + sr) * LDK + sc]); \
    sr_[i].ks0 = St::ld8(&Kh[(long)((k0) + sr) * LDK + sc]); sr_[i].ks1 = St::ld8(&Kh[(long)((k0) + 32 + sr) * LDK + sc]); } while (0)
#define SWRITE(b, i) do { *(bf16x8*)((char*)V_lds + (b) * SHM_V + vst0) = St::tobf(sr_[i].vs0);          \
    *(bf16x8*)((char*)V_lds + (b) * SHM_V + vst1) = St::tobf(sr_[i].vs1); int kc = sc * 2;               \
    *(bf16x8*)((char*)K_lds + (b) * SHM_K + KSWZ(sr, kc)) = St::tobf(sr_[i].ks0);                       \
    *(bf16x8*)((char*)K_lds + (b) * SHM_K + KSWZ(32 + sr, kc)) = St::tobf(sr_[i].ks1); } while (0)
#define SWAIT() do { if constexpr (SDEPTH == 2) asm volatile("s_waitcnt vmcnt(4)" ::: "memory"); else asm volatile("s_waitcnt vmcnt(0)" ::: "memory"); } while (0)
#define RESC(a) do { if (__any((a) < 1.f)) { if (hi == 0) al_l[r32] = (a); asm volatile("s_waitcnt lgkmcnt(0)" ::: "memory"); \
    for (int d = 0; d < 4; ++d) for (int r = 0; r < 16; ++r) o[d][r] *= al_l[crow(r, hi)]; } } while (0)
  f32x16 pA0, pA1, pB0, pB1; float mnA, mnB, alA, alB; bf16x8 pa0, pa1, pa2, pa3; const int NT = seq / KVBLK;
  constexpr int SE = 0, SO = SDEPTH - 1;
  SLOAD(SE, 0); asm volatile("s_waitcnt vmcnt(0)" ::: "memory"); SWRITE(0, SE); __syncthreads();
  qkt(pA0, pA1, K_lds, qr, r32, hi); partialSM(pA0, pA1, m_reg, mnA, alA);
  SLOAD(SO, KVBLK); if constexpr (SDEPTH == 2) { if (2 < NT) SLOAD(SE, 2 * KVBLK); }
  SWAIT(); SWRITE(1, SO); __syncthreads();
  for (int j = 1; j + 1 < NT; j += 2) {
    SBAR(); qkt(pB0, pB1, (bf16*)((char*)K_lds + SHM_K), qr, r32, hi);
    finishSM(pA0, pA1, alA, l_reg, pa0, pa1, pa2, pa3); SBAR();
    SLOAD(SO, (j + SDEPTH) * KVBLK); SBAR();
    pv_d0(o, vb0, pa0, pa1, pa2, pa3); partialSM(pB0, pB1, m_reg, mnB, alB);
    __syncthreads(); SWAIT(); SWRITE(0, SE);
    RESC(alB); __syncthreads();
    SBAR(); qkt(pA0, pA1, K_lds, qr, r32, hi);
    finishSM(pB0, pB1, alB, l_reg, pa0, pa1, pa2, pa3); SBAR();
    if (SDEPTH == 1 || j + 3 < NT) SLOAD(SE, (j + 1 + SDEPTH) * KVBLK); SBAR();
    pv_d0(o, vb0 + (int)SHM_V, pa0, pa1, pa2, pa3); partialSM(pA0, pA1, m_reg, mnA, alA);
    __syncthreads(); SWAIT(); SWRITE(1, SO);
    RESC(alA); __syncthreads();
  }
  SBAR(); qkt(pB0, pB1, (bf16*)((char*)K_lds + SHM_K), qr, r32, hi);
  finishSM(pA0, pA1, alA, l_reg, pa0, pa1, pa2, pa3); SBAR();
  pv_d0(o, vb0, pa0, pa1, pa2, pa3); partialSM(pB0, pB1, m_reg, mnB, alB);
  __syncthreads(); RESC(alB);
  finishSM(pB0, pB1, alB, l_reg, pa0, pa1, pa2, pa3); SBAR();
  pv_d0(o, vb0 + (int)SHM_V, pa0, pa1, pa2, pa3);
  if (hi == 0) li_l[r32] = l_reg; asm volatile("s_waitcnt lgkmcnt(0)" ::: "memory");
  float rli[16];
#pragma unroll
  for (int r = 0; r < 16; ++r) rli[r] = __builtin_amdgcn_rcpf(li_l[crow(r, hi)]);
  bf16* Ow = Ob + (long)(wid * QBLK) * LDO;
#pragma unroll
  for (int r = 0; r < 16; ++r) { int orow = crow(r, hi);
    for (int d0 = 0; d0 < 4; ++d0) Ow[(long)orow * LDO + d0 * 32 + r32] = __float2bfloat16(o[d0][r] * rli[r]); }
  asm volatile("s_waitcnt vmcnt(0) lgkmcnt(0)" ::: "memory"); __syncthreads();
#undef SLOAD
#undef SWRITE
#undef SWAIT
#undef RESC
}
#undef SBAR
#undef KSWZ
}
#define LAS __attribute__((address_space(3)))
typedef unsigned short bf16u;
typedef float f32x4 __attribute__((ext_vector_type(4)));
typedef unsigned v4u __attribute__((ext_vector_type(4)));
typedef unsigned v2u __attribute__((ext_vector_type(2)));
typedef short bf16x8 __attribute__((ext_vector_type(8)));
constexpr int NWAVES = 8, NTHR = 512;
constexpr size_t MiB = 1u << 20;
constexpr size_t WS_MOD = 1 * MiB;
constexpr size_t WS_ROPE = WS_MOD + 512 * 1024;
constexpr size_t WS_XCTX = 2 * MiB;
constexpr size_t WS_STATS = 7 * MiB + 512 * 1024;
constexpr size_t WS_PART = 4 * MiB;
constexpr size_t WS_FFN_IN = 8 * MiB;
constexpr size_t WS_FFN_OUT = WS_FFN_IN + 44 * MiB;
constexpr size_t WS_GOUT = WS_FFN_OUT + 22 * MiB;
constexpr size_t WS_WQKV = WS_GOUT + 6 * MiB;
constexpr size_t WS_WO = WS_WQKV + 3 * MiB;
constexpr size_t WS_A = WS_WO + 2 * MiB;
constexpr size_t WS_GIN = WS_A + 65 * MiB;
constexpr size_t WS_R1 = WS_GIN + 12 * MiB;
constexpr size_t WS_R2 = WS_R1 + 195 * MiB;
constexpr size_t WS_CPART = WS_R2 + 99 * MiB;
constexpr size_t WS_END = WS_CPART + 24 * MiB;
static_assert(WS_A == 85 * MiB && WS_END == 480 * MiB, "ws map");
static_assert((size_t)MTOT * DM * 2 == 65 * MiB, "A size");
constexpr size_t R1_Q = 0, R1_K = 64 * MiB, R1_V = 64 * MiB + 17 * MiB;
constexpr int LDS_BYTES = 147456;

struct Params {
    const float* x; const float* c; const float* ctx; const float* c_ctx; const float* w_mod; const float* b_mod;
    const float* ln_g; const float* ln_b; const float* ffn_w_in; const float* ffn_w_out; const float* gmlp_w_in;
    const float* gmlp_ln_g; const float* gmlp_ln_b; const float* gmlp_w_s; const float* gmlp_b_s; const float* gmlp_w_out;
    const float* attn_w_qkv; const float* attn_q_norm; const float* attn_k_norm; const float* attn_w_o;
    float* out; unsigned char* ws; int ph_lo, ph_hi;
};

__device__ __forceinline__ unsigned f2bf(float f) { unsigned u = __builtin_bit_cast(unsigned, f); return (u + 0x7fffu + ((u >> 16) & 1u)) >> 16; }
__device__ __forceinline__ unsigned pk2(float lo, float hi) { unsigned r; asm volatile("v_cvt_pk_bf16_f32 %0, %1, %2" : "=v"(r) : "v"(lo), "v"(hi)); return r; }
__device__ __forceinline__ float bf_lo(unsigned w) { return __builtin_bit_cast(float, w << 16); }
__device__ __forceinline__ float bf_hi(unsigned w) { return __builtin_bit_cast(float, w & 0xffff0000u); }
__device__ __forceinline__ float wave_sum(float v) {
#pragma unroll
    for (int o = 1; o < 64; o <<= 1) v += __shfl_xor(v, o);
    return v;
}
__device__ __forceinline__ void transpose_item(const float* W, int K, int N, bf16u* WT, int mode, LAS float* scr, int item, int lane) {
    const int nblk = N / 64, kb = item / nblk, nb = item % nblk, k0 = 64 * kb, n0 = 64 * nb;
    int d0 = n0;
    if (mode == 1) { const int isu = n0 >= DFF, j = isu ? n0 - DFF : n0; d0 = (j >> 7) * 256 + isu * 128 + (j & 127); }
    const float* src = W + (size_t)k0 * N + n0 + lane;
    float t[64];
#pragma unroll
    for (int kk = 0; kk < 64; ++kk) t[kk] = src[(size_t)kk * N];
#pragma unroll
    for (int kk = 0; kk < 64; ++kk) scr[kk * 65 + lane] = t[kk];
    asm volatile("s_waitcnt lgkmcnt(0)" ::: "memory");
    const int c = lane & 7;
#pragma unroll
    for (int j = 0; j < 8; ++j) { const int n = (lane >> 3) + 8 * j; const LAS float* sp = scr + (8 * c) * 65 + n;
        v4u o; o.x = pk2(sp[0 * 65], sp[1 * 65]); o.y = pk2(sp[2 * 65], sp[3 * 65]); o.z = pk2(sp[4 * 65], sp[5 * 65]); o.w = pk2(sp[6 * 65], sp[7 * 65]);
        *(v4u*)(WT + (size_t)(d0 + n) * K + k0 + 8 * c) = o; }
    asm volatile("s_waitcnt lgkmcnt(0)" ::: "memory");
}

__device__ __forceinline__ void phase_prologue(const Params& p, LAS unsigned char* lds, int G) {
    const int tid = opaque_tid(), lane = tid & 63, wave = __builtin_amdgcn_readfirstlane(tid >> 6);
    unsigned char* ws = p.ws;
    LAS float* sc = (LAS float*)lds;
    LAS float* red = (LAS float*)(lds + 12288);
    for (int k = tid; k < 1024; k += NTHR) { const float a = p.c[k], b = p.c[1024 + k], d = p.c_ctx[k];
        sc[k] = a / (1.f + __expf(-a)); sc[1024 + k] = b / (1.f + __expf(-b)); sc[2048 + k] = d / (1.f + __expf(-d)); }
    __syncthreads();
    float* MOD = (float*)(ws + WS_MOD);
    for (int u = blockIdx.x; u < 288; u += G) {
        const int col0 = u * 64, l = col0 / NMOD, j = col0 % NMOD + lane;
        const float* wp = p.w_mod + (size_t)l * 1024 * NMOD + (size_t)(wave * 128) * NMOD + j;
        float a0 = 0.f, a1 = 0.f, a2 = 0.f;
#pragma unroll 8
        for (int k = 0; k < 128; ++k) { const float w = wp[(size_t)k * NMOD]; const int kk = wave * 128 + k; a0 += sc[kk] * w; a1 += sc[1024 + kk] * w; a2 += sc[2048 + kk] * w; }
        red[(wave * 3 + 0) * 64 + lane] = a0; red[(wave * 3 + 1) * 64 + lane] = a1; red[(wave * 3 + 2) * 64 + lane] = a2;
        __syncthreads();
        if (tid < 192) { const int cnd = tid >> 6; float s = 0.f;
#pragma unroll
            for (int w = 0; w < 8; ++w) s += red[(w * 3 + cnd) * 64 + lane];
            MOD[(size_t)(l * 3 + cnd) * NMOD + j] = s + p.b_mod[l * NMOD + j]; }
        __syncthreads();
    }
    { const int g = blockIdx.x * NTHR + tid; if (g < 8192) { const int pos = g >> 5, jf = g & 31;
        const float fr = powf(10000.0f, -(float)jf / 32.0f); const float ang = (float)pos * fr; float sn, cs; sincosf(ang, &sn, &cs);
        float* T = (float*)(ws + WS_ROPE); T[2 * g] = cs; T[2 * g + 1] = sn; } }
    __syncthreads();
    LAS float* scr = (LAS float*)(lds + wave * 16640);
    const int gw = blockIdx.x * NWAVES + wave, NGW = G * NWAVES;
    constexpr int I_FI = 16 * 88, I_FO = 44 * 16, I_GI = 16 * 96, I_GO = 48 * 16, I_QKV = 16 * 24, I_WO = 16 * 16;
    constexpr int NITEMS = 4 * I_FI + 4 * I_FO + I_GI + I_GO + I_QKV + I_WO;
    for (int it = gw; it < NITEMS; it += NGW) {
        int r = it;
        if (r < 4 * I_FI) { const int w = r / I_FI; transpose_item(p.ffn_w_in + (size_t)w * 1024 * 5632, 1024, 5632, (bf16u*)(ws + WS_FFN_IN) + (size_t)w * 5632 * 1024, 1, scr, r % I_FI, lane); continue; } r -= 4 * I_FI;
        if (r < 4 * I_FO) { const int w = r / I_FO; transpose_item(p.ffn_w_out + (size_t)w * DFF * 1024, DFF, 1024, (bf16u*)(ws + WS_FFN_OUT) + (size_t)w * 1024 * DFF, 0, scr, r % I_FO, lane); continue; } r -= 4 * I_FO;
        if (r < I_GI) { transpose_item(p.gmlp_w_in, 1024, 6144, (bf16u*)(ws + WS_GIN), 0, scr, r, lane); continue; } r -= I_GI;
        if (r < I_GO) { transpose_item(p.gmlp_w_out, GH, 1024, (bf16u*)(ws + WS_GOUT), 0, scr, r, lane); continue; } r -= I_GO;
        if (r < I_QKV) { transpose_item(p.attn_w_qkv, 1024, QKVN, (bf16u*)(ws + WS_WQKV), 0, scr, r, lane); continue; } r -= I_QKV;
        transpose_item(p.attn_w_o, 1024, 1024, (bf16u*)(ws + WS_WO), 0, scr, r, lane);
    }
}

__device__ __forceinline__ void phase_rowpass(const float* src_lat, const float* src_ctx, float* dst_lat, float* dst_ctx, bool do_ln, const float* lng, const float* lnb,
                                              const float* mod, int ksh, int ksc, bf16u* A, int nrows, int G,
                                              const float* cpart, int cns, const float* cres, const float* cgate, float cgs, float* stats) {
    const int tid = opaque_tid(), lane = tid & 63, wave = tid >> 6;
    const int gw = blockIdx.x * NWAVES + wave, NGW = G * NWAVES;
    const int r0 = gw, r1 = nrows;
    if (r0 >= r1) return;
    f32x4 lg[4], lb[4], sh[4], sc[4];
#pragma unroll
    for (int j = 0; j < 4; ++j) { lg[j] = do_ln ? ((const f32x4*)lng)[lane + 64 * j] : (f32x4){1.f, 1.f, 1.f, 1.f}; lb[j] = do_ln ? ((const f32x4*)lnb)[lane + 64 * j] : (f32x4){0.f, 0.f, 0.f, 0.f};
        sh[j] = (f32x4){0.f, 0.f, 0.f, 0.f}; sc[j] = sh[j]; }
    int cur_cond = -1;
    f32x4 v[4], vn[4];
    { const bool isctx = r0 >= NLAT; const float* s = isctx ? src_ctx + (size_t)(r0 - NLAT) * DM : src_lat + (size_t)r0 * DM;
#pragma unroll
      for (int j = 0; j < 4; ++j) v[j] = ((const f32x4*)s)[lane + 64 * j]; }
    for (int r = r0; r < r1; r += NGW) {
        const bool isctx = r >= NLAT; const int cond = r < SEQL ? 0 : (r < NLAT ? 1 : 2);
        if (r + NGW < r1) { const bool nctx = r + NGW >= NLAT; const float* s = nctx ? src_ctx + (size_t)(r + NGW - NLAT) * DM : src_lat + (size_t)(r + NGW) * DM;
#pragma unroll
            for (int j = 0; j < 4; ++j) vn[j] = ((const f32x4*)s)[lane + 64 * j]; }
        if (mod && cond != cur_cond) { cur_cond = cond; const float* mp = mod + (size_t)cond * NMOD;
#pragma unroll
            for (int j = 0; j < 4; ++j) { sh[j] = ((const f32x4*)(mp + ksh * 1024))[lane + 64 * j]; sc[j] = ((const f32x4*)(mp + ksc * 1024))[lane + 64 * j] + 1.0f; } }
        if (isctx && cpart) {
            const float* rr = cres + (size_t)(r - NLAT) * DM;
#pragma unroll
            for (int j = 0; j < 4; ++j) { f32x4 a = (f32x4){0.f, 0.f, 0.f, 0.f};
                for (int sl = 0; sl < cns; ++sl) a += ((const f32x4*)(cpart + (size_t)sl * NCTXR * DM + (size_t)(r - NLAT) * DM))[lane + 64 * j];
                v[j] = ((const f32x4*)rr)[lane + 64 * j] * ALPHA_C + ((const f32x4*)cgate)[lane + 64 * j] * cgs * a; }
        }
        if (do_ln) {
            float sm = 0.f;
#pragma unroll
            for (int j = 0; j < 4; ++j) sm += (v[j].x + v[j].y) + (v[j].z + v[j].w);
            const float mean = wave_sum(sm) * (1.f / DM); float s2 = 0.f;
#pragma unroll
            for (int j = 0; j < 4; ++j) { v[j] = v[j] - mean; s2 += (v[j].x * v[j].x + v[j].y * v[j].y) + (v[j].z * v[j].z + v[j].w * v[j].w); }
            const float rstd = 1.f / sqrtf(wave_sum(s2) * (1.f / DM) + LN_EPS_C);
            float* d = isctx ? dst_ctx + (size_t)(r - NLAT) * DM : dst_lat + (size_t)r * DM;
            const bool wr_x = isctx || stats == nullptr;
            if (!wr_x && lane == 0) *(float2*)(stats + (size_t)r * 2) = make_float2(mean, rstd);
#pragma unroll
            for (int j = 0; j < 4; ++j) { v[j] = v[j] * rstd * lg[j] + lb[j]; if (wr_x) ((f32x4*)d)[lane + 64 * j] = v[j]; }
        }
        if (mod) {
            v2u* a = (v2u*)(A + (size_t)r * DM);
#pragma unroll
            for (int j = 0; j < 4; ++j) { const f32x4 o = v[j] * sc[j] + sh[j]; v2u w; w.x = pk2(o.x, o.y); w.y = pk2(o.z, o.w); a[lane + 64 * j] = w; }
        }
#pragma unroll
        for (int j = 0; j < 4; ++j) v[j] = vn[j];
    }
}

__device__ __forceinline__ void phase_spatial(const Params& p, LAS unsigned char* lds, int chunk0, int nchunks, int G) {
    const int tid = opaque_tid(), lane = tid & 63, wave = __builtin_amdgcn_readfirstlane(tid >> 6), fr = lane & 15, fq = lane >> 4;
    LAS float* mu = (LAS float*)lds; LAS float* rs = mu + 128; LAS float* s0a = mu + 256; LAS float* s1a = mu + 384;
    LAS unsigned char* wl = lds + 2048;
    const bf16u* VT = (const bf16u*)(p.ws + WS_R2); bf16u* U = (bf16u*)(p.ws + WS_R1); const float* part = (const float*)(p.ws + WS_PART);
    const int nunits = nchunks * 8;
    for (int un = blockIdx.x; un < nunits; un += G) {
        const int crel = un >> 3, g = un & 7, cabs = chunk0 + crel;
        __syncthreads();
        if (tid < 128) { float S = 0.f, Q = 0.f; const int col = crel * 128 + tid;
#pragma unroll
            for (int t = 0; t < 24; ++t) { const float2 pq = *(const float2*)(part + ((size_t)t * VT_COLS + col) * 2); S += pq.x; Q += pq.y; }
            const float mean = S * (1.f / GH); const float var = fmaxf(Q * (1.f / GH) - mean * mean, 0.f); mu[tid] = mean; rs[tid] = 1.f / sqrtf(var + LN_EPS_C); }
        const int cbase = g * 384 + wave * 48;
        const bf16u* vt = VT + ((size_t)crel * GH + cbase) * 128;
        bf16x8 vf[3][4];
#pragma unroll
        for (int cb = 0; cb < 3; ++cb)
#pragma unroll
            for (int ks = 0; ks < 4; ++ks) vf[cb][ks] = *(const bf16x8*)(vt + (cb * 16 + fr) * 128 + ks * 32 + fq * 8);
        bf16u* ubase = U + (size_t)(cabs * 128 + fr) * GH + cbase + 4 * fq;
        v2u uu[8][3];
#pragma unroll
        for (int pb = 0; pb < 8; ++pb)
#pragma unroll
            for (int cb = 0; cb < 3; ++cb) uu[pb][cb] = *(const v2u*)(ubase + (size_t)(pb * 16) * GH + cb * 16);
        f32x4 lg[3], lb[3];
#pragma unroll
        for (int cb = 0; cb < 3; ++cb) { lg[cb] = *(const f32x4*)(p.gmlp_ln_g + cbase + cb * 16 + 4 * fq); lb[cb] = *(const f32x4*)(p.gmlp_ln_b + cbase + cb * 16 + 4 * fq); }
        float bsv[8];
#pragma unroll
        for (int pb = 0; pb < 8; ++pb) bsv[pb] = p.gmlp_b_s[g * 128 + pb * 16 + fr];
        const int pw = tid >> 2, qs = (tid & 3) * 32;
        const float* wrow = p.gmlp_w_s + ((size_t)g * 128 + pw) * 128 + qs;
        f32x4 wv[8];
#pragma unroll
        for (int i = 0; i < 8; ++i) wv[i] = *(const f32x4*)(wrow + 4 * i);
        __syncthreads();
        { float s0 = 0.f, s1 = 0.f;
#pragma unroll
          for (int i = 0; i < 4; ++i) { const int q0 = qs + 8 * i;
              const f32x4 r0 = *(const LAS f32x4*)(rs + q0), r1 = *(const LAS f32x4*)(rs + q0 + 4), m0 = *(const LAS f32x4*)(mu + q0), m1 = *(const LAS f32x4*)(mu + q0 + 4);
              const f32x4 w0 = wv[2 * i], w1 = wv[2 * i + 1]; const f32x4 a = w0 * r0, b = w1 * r1;
              v4u w; w.x = pk2(a.x, a.y); w.y = pk2(a.z, a.w); w.z = pk2(b.x, b.y); w.w = pk2(b.z, b.w);
              s0 += (w0.x + w0.y) + (w0.z + w0.w) + (w1.x + w1.y) + (w1.z + w1.w);
              s1 += bf_lo(w.x) * m0.x + bf_hi(w.x) * m0.y + bf_lo(w.y) * m0.z + bf_hi(w.y) * m0.w + bf_lo(w.z) * m1.x + bf_hi(w.z) * m1.y + bf_lo(w.w) * m1.z + bf_hi(w.w) * m1.w;
              *(LAS v4u*)(wl + pw * 272 + q0 * 2) = w; }
          s0 += __shfl_xor(s0, 1); s0 += __shfl_xor(s0, 2); s1 += __shfl_xor(s1, 1); s1 += __shfl_xor(s1, 2);
          if ((tid & 3) == 0) { s0a[pw] = s0; s1a[pw] = s1; } }
        __syncthreads();
#pragma unroll
        for (int pb = 0; pb < 8; ++pb) {
            const int pr = pb * 16 + fr;
            bf16x8 wf[4];
#pragma unroll
            for (int ks = 0; ks < 4; ++ks) wf[ks] = *(const LAS bf16x8*)(wl + pr * 272 + (ks * 32 + fq * 8) * 2);
            const float s0 = s0a[pr], s1 = s1a[pr];
            f32x4 acc[3];
#pragma unroll
            for (int cb = 0; cb < 3; ++cb) { acc[cb] = (f32x4){0.f, 0.f, 0.f, 0.f};
#pragma unroll
                for (int ks = 0; ks < 4; ++ks) acc[cb] = __builtin_amdgcn_mfma_f32_16x16x32_bf16(vf[cb][ks], wf[ks], acc[cb], 0, 0, 0); }
#pragma unroll
            for (int cb = 0; cb < 3; ++cb) { const v2u u2 = uu[pb][cb];
                const f32x4 val = lg[cb] * (acc[cb] - s1) + lb[cb] * s0 + bsv[pb];
                v2u o; o.x = pk2(bf_lo(u2.x) * val.x, bf_hi(u2.x) * val.y); o.y = pk2(bf_lo(u2.y) * val.z, bf_hi(u2.y) * val.w);
                *(v2u*)(ubase + (size_t)(pb * 16) * GH + cb * 16) = o; }
        }
    }
}

__device__ __forceinline__ void phase_qknorm(const Params& p, int G) {
    const int tid = opaque_tid(), lane = tid & 63, wave = tid >> 6, k = lane & 31, hsel = lane >> 5;
    const int gw = blockIdx.x * NWAVES + wave, NGW = G * NWAVES;
    bf16u* Q = (bf16u*)(p.ws + WS_R1 + R1_Q); bf16u* KB = (bf16u*)(p.ws + WS_R1 + R1_K);
    const float* T = (const float*)(p.ws + WS_ROPE);
    const float g1a = p.attn_q_norm[2 * k], g1b = p.attn_q_norm[2 * k + 1], g2a = p.attn_q_norm[64 + 2 * k], g2b = p.attn_q_norm[65 + 2 * k];
    const float h1a = p.attn_k_norm[2 * k], h1b = p.attn_k_norm[2 * k + 1], h2a = p.attn_k_norm[64 + 2 * k], h2b = p.attn_k_norm[65 + 2 * k];
    const int jf = (2 * k) & 31;
    constexpr int NK = 2 * KVROWS;
    for (int it = gw; it < NLAT + NK; it += NGW) {
        const bool isq = it < NLAT;
        bf16u* base; int t; bool rope = true; int np;
        if (isq) { base = Q + (size_t)it * DM + hsel * 128; t = it & (SEQL - 1); np = 4; }
        else { const int kr = it - NLAT; const int rb = kr % KVROWS; base = KB + (size_t)kr * 256 + hsel * 128; rope = rb >= CTXL; t = rb - CTXL; np = 1; }
        const float ga = isq ? g1a : h1a, gb = isq ? g1b : h1b, gc = isq ? g2a : h2a, gd = isq ? g2b : h2b;
        unsigned w1[4], w2[4];
#pragma unroll
        for (int hp = 0; hp < 4; ++hp) if (hp < np) { w1[hp] = *(const unsigned*)(base + hp * 256 + 2 * k); w2[hp] = *(const unsigned*)(base + hp * 256 + 64 + 2 * k); }
        f32x4 cs = (f32x4){1.f, 0.f, 1.f, 0.f};
        if (rope) { const int pos = k < 16 ? (t >> 6) : (t & 63); cs = *(const f32x4*)(T + ((size_t)pos * 32 + jf) * 2); }
#pragma unroll
        for (int hp = 0; hp < 4; ++hp) if (hp < np) {
            float x1a = bf_lo(w1[hp]), x1b = bf_hi(w1[hp]), x2a = bf_lo(w2[hp]), x2b = bf_hi(w2[hp]);
            float ss = x1a * x1a + x1b * x1b + x2a * x2a + x2b * x2b;
#pragma unroll
            for (int o = 1; o < 32; o <<= 1) ss += __shfl_xor(ss, o);
            const float rstd = 1.f / sqrtf(ss * (1.f / 128.f) + RMS_EPS_C);
            x1a *= rstd * ga; x1b *= rstd * gb; x2a *= rstd * gc; x2b *= rstd * gd;
            const float y1a = x1a * cs.x - x2a * cs.y, y2a = x2a * cs.x + x1a * cs.y, y1b = x1b * cs.z - x2b * cs.w, y2b = x2b * cs.z + x1b * cs.w;
            *(unsigned*)(base + hp * 256 + 2 * k) = pk2(y1a, y1b); *(unsigned*)(base + hp * 256 + 64 + 2 * k) = pk2(y2a, y2b); }
    }
}

__device__ __forceinline__ void phase_attn(const Params& p, unsigned char* lds_generic, int G) {
    const att::bf16* Q = (const att::bf16*)(p.ws + WS_R1 + R1_Q); const att::bf16* KB = (const att::bf16*)(p.ws + WS_R1 + R1_K); const att::bf16* VB = (const att::bf16*)(p.ws + WS_R1 + R1_V);
    att::bf16* O = (att::bf16*)(p.ws + WS_R2);
    for (int L = blockIdx.x; L < 1024; L += G) {
        const int b = L >> 9, kvh = (L >> 8) & 1, hq = L & 3, qb = (L >> 2) & 63, h = kvh * 4 + hq;
        const size_t q0 = ((size_t)b * SEQL + (size_t)qb * 256) * DM + h * 128, k0 = (size_t)b * KVROWS * 256 + kvh * 128;
        att::attn_dense_body(Q + q0, KB + k0, VB + k0, O + q0, KVROWS, (char*)lds_generic);
    }
}

#define XB_TMO      128
#define XB_XCNT(j)  (256  + 64 * (j))
#define XB_XSUB(j)  (1280 + 64 * (j))
#define XB_XGEN(j)  (2304 + 64 * (j))
#define XB_TOP      3328
#define XB_TOPGEN   3392
#define XCD_BAR_WORDS 3456
#define XB_SPIN_CAP (1u << 18)

__device__ __forceinline__ unsigned xb_ld(unsigned* p)              { return __hip_atomic_load(p, __ATOMIC_RELAXED, __HIP_MEMORY_SCOPE_AGENT); }
__device__ __forceinline__ unsigned xb_add(unsigned* p, unsigned v) { return __hip_atomic_fetch_add(p, v, __ATOMIC_RELAXED, __HIP_MEMORY_SCOPE_AGENT); }
__device__ __forceinline__ unsigned xb_xcc_id() { return (unsigned)__builtin_amdgcn_s_getreg((3 << 11) | 20) & 0xFu; }
#define XB_SPIN(cond, bar) do { unsigned _sp = 0; while (cond) { __builtin_amdgcn_s_sleep(1); \
    if ((++_sp & 255u) == 0u) { if (xb_ld(&(bar)[XB_TMO])) break; if (_sp > XB_SPIN_CAP) { atomicAdd(&(bar)[XB_TMO], 1u); break; } } } } while (0)

struct XcdBarrier {
    unsigned* bar; unsigned x;
    volatile LAS unsigned* st;
};

__device__ __forceinline__ XcdBarrier xcd_barrier_post(unsigned* bar, volatile LAS unsigned* st) {
    XcdBarrier b; b.bar = bar; b.x = xb_xcc_id(); b.st = st;
    if (threadIdx.x == 0) (void)xb_add(&bar[XB_XCNT(b.x)], 1u);
    return b;
}
__device__ __forceinline__ void xcd_barrier_complete(unsigned* bar, unsigned x, unsigned& nloc, unsigned& nx) {
    const unsigned G = gridDim.x * gridDim.y * gridDim.z;
    unsigned sum, cnt, mine, sp = 0u;
    for (;;) {
        sum = 0u; cnt = 0u; mine = 0u;
#pragma unroll
        for (unsigned j = 0; j < 16; ++j) { const unsigned c = xb_ld(&bar[XB_XCNT(j)]); sum += c; cnt += (c > 0u) ? 1u : 0u; mine = (j == x) ? c : mine; }
        if (sum == G) break;
        __builtin_amdgcn_s_sleep(1);
        if ((++sp & 255u) == 0u) { if (xb_ld(&bar[XB_TMO])) break; if (sp > XB_SPIN_CAP) { atomicAdd(&bar[XB_TMO], 1u); break; } }
    }
    nloc = mine > 0u ? mine : 1u; nx = cnt > 0u ? cnt : 1u;
}

__device__ __forceinline__ void xcd_barrier(const XcdBarrier& b) {
    asm volatile("s_waitcnt vmcnt(0)" ::: "memory");
    __syncthreads();
    if (threadIdx.x == 0) {
        unsigned* bar = b.bar;
        __builtin_amdgcn_s_waitcnt(0);
        unsigned nloc = b.st[0], nx = b.st[1];
        if (nloc == 0u) { xcd_barrier_complete(bar, b.x, nloc, nx); b.st[0] = nloc; b.st[1] = nx; }
        const unsigned old = xb_add(&bar[XB_XSUB(b.x)], 1u);
        const unsigned gen = old / nloc;
        if (old + 1u == (gen + 1u) * nloc) {
            __builtin_amdgcn_fence(__ATOMIC_RELEASE, "agent");
            asm volatile("s_waitcnt vmcnt(0)" ::: "memory");
            const unsigned og = xb_add(&bar[XB_TOP], 1u);
            const unsigned tg = og / nx;
            if (og + 1u == (tg + 1u) * nx) xb_add(&bar[XB_TOPGEN], 1u);
            else XB_SPIN(xb_ld(&bar[XB_TOPGEN]) == tg, bar);
            __builtin_amdgcn_fence(__ATOMIC_ACQUIRE, "agent");
            xb_add(&bar[XB_XGEN(b.x)], 1u);
            asm volatile("s_waitcnt vmcnt(0)" ::: "memory");
        } else {
            XB_SPIN(xb_ld(&bar[XB_XGEN(b.x)]) == gen, bar);
            __builtin_amdgcn_fence(__ATOMIC_ACQUIRE, "agent");
            asm volatile("s_waitcnt vmcnt(0)" ::: "memory");
        }
    }
    __syncthreads();
}

enum { T_PRO = 0, T_ROW, T_FFN1, T_RESID, T_GIN, T_SPAT, T_QKV, T_ROPE, T_ATTN };
constexpr int NPHASE = 25;
__global__ void __launch_bounds__(NTHR, 2) mega(Params p) {
    extern __shared__ __attribute__((aligned(16))) unsigned char lds[];
    LAS unsigned char* ldsl = (LAS unsigned char*)lds;
    const int G = gridDim.x;
    unsigned char* ws = p.ws;
    volatile LAS unsigned* MISC = (volatile LAS unsigned*)(ldsl + 147200);
    if (threadIdx.x < 64) MISC[threadIdx.x] = 0u;
    __syncthreads();
    XcdBarrier bar = xcd_barrier_post((unsigned*)ws, MISC + 8);
    float* MOD = (float*)(ws + WS_MOD);
    bf16u* A = (bf16u*)(ws + WS_A); bf16u* R1 = (bf16u*)(ws + WS_R1); bf16u* R2 = (bf16u*)(ws + WS_R2);
    float* XL = p.out; float* XC = (float*)(ws + WS_XCTX);
    bool dup_done = false; (void)dup_done;
    for (int ph = p.ph_lo; ph < p.ph_hi; ++ph) {
        int type = T_ROW, layer = 0, a0 = 0, a1 = 0, a2 = 0, rows = MTOT;
        int cns = 0, cgl = 0, cgk = 0, cfirst = 0;
        switch (ph) {
            case 0: type = T_PRO; break;
            case 1: type = T_ROW; layer = 0; a0 = -1; a1 = 0; break;
            case 2: type = T_FFN1; a0 = 0; break;
            case 3: type = T_RESID; a0 = 0; layer = 0; a1 = 2; a2 = 1; break;
            case 4: type = T_ROW; layer = 0; a0 = 0; a1 = 3; cns = 11; cgl = 0; cgk = 2; cfirst = 1; break;
            case 5: type = T_GIN; a0 = 0; break;
            case 6: type = T_SPAT; a0 = 0; break;
            case 7: type = T_GIN; a0 = 1; break;
            case 8: type = T_SPAT; a0 = 1; break;
            case 9: type = T_RESID; a0 = 4; layer = 0; a1 = 5; cns = 1; cgk = 0; break;
            case 10: type = T_ROW; layer = 0; a0 = 1; a1 = 6; cns = 12; cgl = 0; cgk = 5; break;
            case 11: type = T_FFN1; a0 = 1; break;
            case 12: type = T_RESID; a0 = 1; layer = 0; a1 = 8; cns = 1; cgk = 1; break;
            case 13: type = T_ROW; layer = 1; a0 = 2; a1 = 0; cns = 11; cgl = 0; cgk = 8; break;
            case 14: type = T_FFN1; a0 = 2; break;
            case 15: type = T_RESID; a0 = 2; layer = 1; a1 = 2; cns = 1; cgk = 2; break;
            case 16: type = T_ROW; layer = 1; a0 = 3; a1 = 3; cns = 11; cgl = 1; cgk = 2; break;
            case 17: type = T_QKV; break;
            case 18: type = T_ROPE; break;
            case 19: type = T_ATTN; break;
            case 20: type = T_RESID; a0 = 5; layer = 1; a1 = 5; rows = NLAT; cns = 1; cgk = 3; break;
            case 21: type = T_ROW; layer = 1; a0 = 4; a1 = 6; rows = NLAT; break;
            case 22: type = T_FFN1; a0 = 3; rows = NLAT; break;
            case 23: type = T_RESID; a0 = 3; layer = 1; a1 = 8; rows = NLAT; cns = 1; cgk = 4; break;
            default: type = T_ROW; layer = 1; a0 = 5; a1 = -1; rows = NLAT; break;
        }
#ifndef PHM
#define PHM 0x1ff
#endif
        if (type == T_PRO) { if (PHM & 1) phase_prologue(p, ldsl, G); }
        else if (type == T_ROW) { if (PHM & 2) {
            const bool first = (a0 < 0);
            phase_rowpass(first ? p.x : XL, first ? p.ctx : XC, XL, XC, !first, p.ln_g + (first ? 0 : a0) * DM, p.ln_b + (first ? 0 : a0) * DM,
                          a1 >= 0 ? MOD + (size_t)layer * 3 * NMOD : nullptr, a1, a1 + 1, A, rows, G,
                          cns ? (const float*)(ws + WS_CPART) : nullptr, cns, cfirst ? p.ctx : XC, MOD + (size_t)(cgl * 3 + 2) * NMOD + cgk * 1024, cgk == 5 ? 1.0f : 0.5f, a1 >= 0 ? (float*)(ws + WS_STATS) : nullptr); }
        } else if (type == T_FFN1) { if (PHM & 4) {
            pg8::Gemm g{A, (const bf16u*)(ws + WS_FFN_IN) + (size_t)a0 * 5632 * 1024, rows, 5632, 1024};
            pg8::StaticOrder S; S.init(rows, 5632, G, (int)blockIdx.x);
            pg8::EpiSwiglu E{R1};
            pg8::gemm_phase<pg8::EpiSwiglu, pg8::StaticOrder, true, true>(ldsl, g, S, E); }
        } else if (type == T_RESID) { if (PHM & 8) {
            const bf16u* Ain = a0 == 5 ? R2 : R1; const int K = a0 < 4 ? DFF : (a0 == 4 ? GH : DM);
            const bf16u* W = a0 < 4 ? (const bf16u*)(ws + WS_FFN_OUT) + (size_t)a0 * 1024 * DFF : (a0 == 4 ? (const bf16u*)(ws + WS_GOUT) : (const bf16u*)(ws + WS_WO));
            pg8::Gemm g{Ain, W, rows, 1024, K};
            pg8::ResidOrder S; S.init(rows == MTOT ? K / 256 : 0, K / 64, G, (int)blockIdx.x);
            pg8::EpiResid E{a2 ? p.x : XL, a2 ? p.ctx : XC, XL, XC, MOD + (size_t)layer * 3 * NMOD + a1 * 1024, (a1 == 5) ? 1.0f : 0.5f, (float*)(ws + WS_CPART),
                              cns ? (const float*)(ws + WS_STATS) : nullptr, p.ln_g + cgk * DM, p.ln_b + cgk * DM};
            pg8::gemm_phase<pg8::EpiResid, pg8::ResidOrder, true, true>(ldsl, g, S, E); }
        } else if (type == T_GIN) { if (PHM & 16) {
            const int p0 = a0 ? 64 : 0, np = a0 ? 66 : 64;
            pg8::Gemm g{A, A, 0, 0, 1024};
            pg8::GmlpOrder S; S.init(p0, np, G, (int)blockIdx.x);
            pg8::EpiGmlp E{R1, R2, (float*)(ws + WS_PART), p0};
            pg8::gemm_phase<pg8::EpiGmlp, pg8::GmlpOrder, true, true>(ldsl, g, S, E); }
        } else if (type == T_SPAT) {
            if (PHM & 32) phase_spatial(p, ldsl, a0 ? 128 : 0, a0 ? 132 : 128, G);
        } else if (type == T_QKV) { if (PHM & 64) {
            pg8::Gemm g{A, (const bf16u*)(ws + WS_WQKV), 0, 0, 1024};
            pg8::QkvOrder S; S.init(G, (int)blockIdx.x);
            pg8::EpiQKV E{(bf16u*)(ws + WS_R1 + R1_Q), (bf16u*)(ws + WS_R1 + R1_K), (bf16u*)(ws + WS_R1 + R1_V)};
            pg8::gemm_phase<pg8::EpiQKV, pg8::QkvOrder, true, true>(ldsl, g, S, E); }
        } else if (type == T_ROPE) { if (PHM & 128) phase_qknorm(p, G); }
        else { if (PHM & 256) phase_attn(p, lds, G); }
        if (ph + 1 < p.ph_hi) { if (ph == 0) cg::this_grid().sync(); else xcd_barrier(bar); }
#if defined(PROBE_SYNC2)
        if (ph + 1 < p.ph_hi && ph != 0) xcd_barrier(bar);
#endif
#if defined(PROBE_DUP)
        if (ph == (PROBE_DUP) && !dup_done) { dup_done = true; --ph; }
#endif
#if defined(PROBE_DUP_HI)
        if (ph == (PROBE_DUP_HI) && !dup_done) { dup_done = true; ph = (PROBE_DUP_LO) - 1; }
#endif
    }
}

#ifndef MK_N_LAUNCHES
#define MK_N_LAUNCHES 1
#endif
extern "C" void kernel_launch(void* const* d_in, const int* in_sizes, int n_in, void* d_out, int out_size, void* d_ws, size_t ws_size, hipStream_t stream) {
    static int grid = 0;
    if (grid == 0) {
        if (n_in != 20 || out_size != NLAT * DM || ws_size < WS_END) { fprintf(stderr, "kernel_launch: unexpected shapes n_in %d out %d ws %zu\n", n_in, out_size, ws_size); grid = -1; return; }
        int dev = 0, cus = 0, per_cu = 0;
        hipGetDevice(&dev); hipDeviceGetAttribute(&cus, hipDeviceAttributeMultiprocessorCount, dev);
        if (hipFuncSetAttribute((const void*)mega, hipFuncAttributeMaxDynamicSharedMemorySize, LDS_BYTES) != hipSuccess) { fprintf(stderr, "kernel_launch: hipFuncSetAttribute failed\n"); grid = -1; return; }
        hipOccupancyMaxActiveBlocksPerMultiprocessor(&per_cu, (const void*)mega, NTHR, LDS_BYTES);
        if (per_cu < 1) { fprintf(stderr, "kernel_launch: occupancy query says %d blocks per CU\n", per_cu); per_cu = 1; }
        (void)hipGetLastError();
        grid = cus;
    }
    if (grid < 0) return;
    Params p{};
    const float** pp = (const float**)&p;
    for (int i = 0; i < 20; ++i) pp[i] = (const float*)d_in[i];
    p.out = (float*)d_out; p.ws = (unsigned char*)d_ws;
#if MK_N_LAUNCHES == 1
    p.ph_lo = 0; p.ph_hi = NPHASE;
    if (hipMemsetAsync(d_ws, 0, 16384, stream) != hipSuccess) { fprintf(stderr, "kernel_launch: memset failed\n"); return; }
    void* args[] = {&p};
    hipError_t e = hipLaunchCooperativeKernel((const void*)mega, dim3(grid), dim3(NTHR), args, LDS_BYTES, stream);
    if (e != hipSuccess) fprintf(stderr, "cooperative launch failed: %s (grid %d)\n", hipGetErrorString(e), grid);
#else
    for (int ph = 0; ph < NPHASE; ++ph) { p.ph_lo = ph; p.ph_hi = ph + 1; hipLaunchKernelGGL(mega, dim3(grid), dim3(NTHR), LDS_BYTES, stream, p); }
#endif
}
```

```cpp
#include <hip/hip_runtime.h>
#include <hip/hip_cooperative_groups.h>
#include <hip/hip_bf16.h>
#include <cstdio>
#include <cstdint>
namespace cg = cooperative_groups;
__device__ __forceinline__ int opaque_tid() { int t = threadIdx.x; asm volatile("" : "+v"(t)); return t; }
constexpr int DM = 1024, NLAT = 32768, SEQL = 16384, NCTXR = 512, CTXL = 256, MTOT = 33280;
constexpr int NPAN = 130, NPAN_LAT = 128;
constexpr int DFF = 2816, GH = 3072, NMOD = 9216, QKVN = 1536, KVROWS = 16640;
constexpr float ALPHA_C = 1.4142135623730951f;
constexpr float LN_EPS_C = 1e-5f, RMS_EPS_C = 1e-6f;
constexpr int GIN_PAN0 = 130;
constexpr int VT_CHUNKS = 132, VT_COLS = VT_CHUNKS * 128;
namespace pg8 {
#define PG8_LAS __attribute__((address_space(3)))
typedef unsigned short bf16_t;
typedef short bf16x8 __attribute__((ext_vector_type(8)));
typedef float f32x4 __attribute__((ext_vector_type(4)));
typedef unsigned u32x4 __attribute__((ext_vector_type(4)));
constexpr int BM = 256, BK = 64, HALF = 128, HTB = HALF * BK * 2  , STAGE_BYTES = 8 * HTB, NXCD = 8, WGM = 8;

__host__ __device__ __forceinline__ int lds_byte(int r, int c) { const int st = (r >> 4) * 2 + (c >> 5), rr = r & 15, cc = c & 31, ob = rr * 64 + cc * 2; return st * 1024 + (ob ^ (((ob >> 9) & 1) << 5)); }
__host__ __device__ __forceinline__ void stage_rc(int b, int& R, int& C) { const int st = b / 1024, sb = b % 1024, swz = sb ^ (((sb >> 9) & 1) << 5); R = (st >> 1) * 16 + swz / 64; C = (st & 1) * 32 + (swz % 64) / 2; }
__host__ __device__ __forceinline__ int perm32(int rho) { const int n = rho >> 4, i = rho & 15; return 8 * (i >> 2) + 4 * n + (i & 3); }

struct Unit { int pm, pn, kt0, nkt; };
struct Gemm { const bf16_t* A; const bf16_t* Bt; int M, N, K; };

struct StaticOrder {
    int nM, nN, nwg, G, c;
    __host__ __device__ void init(int M, int N, int G_, int c_) { nM = M / BM; nN = N / BM; nwg = nM * nN; G = G_; c = c_; }
    __host__ __device__ bool next(int i, Unit& u) const {
        const long L = (long)i * G + c; if (L >= nwg) return false;
        int wgid = (int)L; { const int q = nwg / NXCD, r = nwg % NXCD, xcd = wgid % NXCD, off = wgid / NXCD; wgid = (xcd < r ? xcd * (q + 1) : r * (q + 1) + (xcd - r) * q) + off; }
        const int nig = WGM * nN, gid = wgid / nig, fm = gid * WGM, gsz = (nM - fm) < WGM ? (nM - fm) : WGM;
        u.pm = fm + ((wgid % nig) % gsz); u.pn = (wgid % nig) / gsz; return true;
    }
    __device__ __forceinline__ void a_ready(const Unit&) const {}
    __device__ __forceinline__ void done(const Unit&) const {}
};

__device__ __forceinline__ unsigned cvt_pk_bf16(float lo, float hi) { unsigned r; asm volatile("v_cvt_pk_bf16_f32 %0, %1, %2" : "=v"(r) : "v"(lo), "v"(hi)); return r; }
typedef float f32x2 __attribute__((ext_vector_type(2)));
__device__ __forceinline__ f32x2 gelu_pk(f32x2 v) {
    const f32x2 av = __builtin_elementwise_abs(v), d = av * 0.2316418882f + 1.0f;
    f32x2 t; t.x = __builtin_amdgcn_rcpf(d.x); t.y = __builtin_amdgcn_rcpf(d.y);
    f32x2 q = t * 0.5307027145f + (-0.7265760135f); q = q * t + 0.7107068705f; q = q * t + (-0.142248368f); q = q * t + 0.127414796f; q = q * t;
    const f32x2 s = (v * v) * (-0.72134752044f);
    f32x2 e; e.x = __builtin_amdgcn_exp2f(s.x); e.y = __builtin_amdgcn_exp2f(s.y);
    const f32x2 m = v * (q * e), r = v - m;
    f32x2 o; o.x = v.x < 0.f ? m.x : r.x; o.y = v.y < 0.f ? m.y : r.y; return o;
}
typedef unsigned u32x2 __attribute__((ext_vector_type(2)));
__device__ __forceinline__ float silu_f(float g) { return g * __builtin_amdgcn_rcpf(1.0f + __builtin_amdgcn_exp2f(-1.4426950408889634f * g)); }
struct EpiSwiglu {
    static constexpr bool PERM = true, AFTER_DRAIN = false;
    bf16_t* H;
    __device__ __forceinline__ void operator()(const f32x4 (&acc)[2][2][4][2], const Unit& u, int wr, int wc, int fr, int fq) const {
        const int row0 = u.pm * BM + wr * 64 + fr, col0 = u.pn * HALF + wc * 32 + 8 * fq;
#pragma unroll
        for (int ai = 0; ai < 2; ++ai)
#pragma unroll
            for (int m = 0; m < 4; ++m) { bf16_t* rowp = H + (size_t)(row0 + ai * HALF + m * 16) * DFF + col0;
                const f32x4 g0 = acc[ai][0][m][0], g1 = acc[ai][0][m][1], u0 = acc[ai][1][m][0], u1 = acc[ai][1][m][1];
                u32x4 w; w.x = cvt_pk_bf16(silu_f(g0[0]) * u0[0], silu_f(g0[1]) * u0[1]); w.y = cvt_pk_bf16(silu_f(g0[2]) * u0[2], silu_f(g0[3]) * u0[3]);
                w.z = cvt_pk_bf16(silu_f(g1[0]) * u1[0], silu_f(g1[1]) * u1[1]); w.w = cvt_pk_bf16(silu_f(g1[2]) * u1[2], silu_f(g1[3]) * u1[3]);
                *(u32x4*)rowp = w; }
    }
};
struct EpiResid {
    static constexpr bool PERM = false, AFTER_DRAIN = false;
    const float* res_lat; const float* res_ctx; float* dst_lat; float* dst_ctx; const float* gate; float gs; float* cpart;
    const float* stats; const float* lng; const float* lnb;
    __device__ __forceinline__ void operator()(const f32x4 (&acc)[2][2][4][2], const Unit& u, int wr, int wc, int fr, int fq) const {
        const bool isctx = u.pm >= NPAN_LAT; const int cond = u.pm < 64 ? 0 : (u.pm < 128 ? 1 : 2);
        const bool raw = isctx && cpart != nullptr;
        const char* rb = (const char*)(isctx ? res_ctx + (size_t)(u.pm - NPAN_LAT) * BM * DM : res_lat + (size_t)u.pm * BM * DM) + (size_t)u.pn * BM * 4;
        char* db = (char*)(raw ? cpart + (size_t)(u.kt0 >> 2) * NCTXR * DM + (size_t)(u.pm - NPAN_LAT) * BM * DM : (isctx ? dst_ctx + (size_t)(u.pm - NPAN_LAT) * BM * DM : dst_lat + (size_t)u.pm * BM * DM)) + (size_t)u.pn * BM * 4;
        const char* gp = (const char*)(gate + cond * NMOD + u.pn * BM);
        const char* lgp = (const char*)(lng + u.pn * BM); const char* lbp = (const char*)(lnb + u.pn * BM);
        const char* stp = (const char*)(stats + (size_t)u.pm * BM * 2);
        unsigned cofs = (unsigned)(wc * 32 + 4 * fq) * 4u;
        unsigned rofs = (unsigned)(wr * 64 + fr);
        asm volatile("" : "+v"(cofs), "+v"(rofs));
        if (raw) {
#pragma unroll
            for (int ai = 0; ai < 2; ++ai)
#pragma unroll
                for (int m = 0; m < 4; ++m) { const unsigned off = (rofs + ai * HALF + m * 16) * (DM * 4u) + cofs;
#pragma unroll
                    for (int bj = 0; bj < 2; ++bj)
#pragma unroll
                        for (int n = 0; n < 2; ++n) *(f32x4*)(db + off + (bj * HALF + n * 16) * 4) = acc[ai][bj][m][n]; }
        } else if (stats != nullptr && !isctx) {
#pragma unroll
            for (int ai = 0; ai < 2; ++ai)
#pragma unroll
                for (int m = 0; m < 4; ++m) { const unsigned rr = rofs + ai * HALF + m * 16, off = rr * (DM * 4u) + cofs;
                    const f32x2 st = *(const f32x2*)(stp + rr * 8u); const float a = st.y * ALPHA_C, b = -st.x * a;
#pragma unroll
                    for (int bj = 0; bj < 2; ++bj)
#pragma unroll
                        for (int n = 0; n < 2; ++n) { const unsigned co = (bj * HALF + n * 16) * 4u;
                            const f32x4 z = *(const f32x4*)(rb + off + co), gv = *(const f32x4*)(gp + cofs + co), lg = *(const f32x4*)(lgp + cofs + co), lb = *(const f32x4*)(lbp + cofs + co);
                            *(f32x4*)(db + off + co) = (z * a + b) * lg + lb * ALPHA_C + gv * gs * acc[ai][bj][m][n]; }
                    asm volatile("" ::: "memory"); }
        } else {
#pragma unroll
            for (int ai = 0; ai < 2; ++ai)
#pragma unroll
                for (int m = 0; m < 4; ++m) { const unsigned off = (rofs + ai * HALF + m * 16) * (DM * 4u) + cofs;
#pragma unroll
                    for (int bj = 0; bj < 2; ++bj)
#pragma unroll
                        for (int n = 0; n < 2; ++n) { const unsigned co = (bj * HALF + n * 16) * 4u; const f32x4 r = *(const f32x4*)(rb + off + co), gv = *(const f32x4*)(gp + cofs + co);
                            *(f32x4*)(db + off + co) = r * ALPHA_C + gv * gs * acc[ai][bj][m][n]; }
                    asm volatile("" ::: "memory"); }
        }
    }
};

struct EpiGmlp {
    static constexpr bool PERM = true, AFTER_DRAIN = false;
    bf16_t* U; bf16_t* VT; float* part; int p0;
    __device__ __forceinline__ void operator()(const f32x4 (&acc)[2][2][4][2], const Unit& u, int wr, int wc, int fr, int fq) const {
        if (u.pm < NPAN) {
            const int row0 = u.pm * BM + wr * 64 + fr, col0 = (u.pn - GIN_PAN0) * BM + wc * 32 + 8 * fq;
#pragma unroll
            for (int ai = 0; ai < 2; ++ai)
#pragma unroll
                for (int m = 0; m < 4; ++m) { bf16_t* rowp = U + (size_t)(row0 + ai * HALF + m * 16) * GH + col0;
#pragma unroll
                    for (int bj = 0; bj < 2; ++bj) { const f32x4 v0 = acc[ai][bj][m][0], v1 = acc[ai][bj][m][1];
                        const f32x2 a = gelu_pk((f32x2){v0[0], v0[1]}), b = gelu_pk((f32x2){v0[2], v0[3]}), c = gelu_pk((f32x2){v1[0], v1[1]}), d = gelu_pk((f32x2){v1[2], v1[3]});
                        u32x4 w; w.x = cvt_pk_bf16(a.x, a.y); w.y = cvt_pk_bf16(b.x, b.y); w.z = cvt_pk_bf16(c.x, c.y); w.w = cvt_pk_bf16(d.x, d.y);
                        *(u32x4*)(rowp + bj * HALF) = w; asm volatile("" ::: "memory"); } }
        } else {
            const int ct = u.pm - (GIN_PAN0 + 12);
            const int crow0 = ct * BM + wr * 64 + fr;
            const int lane = fr + 16 * fq;
#pragma unroll
            for (int bj = 0; bj < 2; ++bj) {
                const int chunk = (u.pn - p0) * 2 + bj; const int q0 = wc * 32 + 8 * fq;
                float s[8], q[8];
#pragma unroll
                for (int j = 0; j < 8; ++j) { s[j] = 0.f; q[j] = 0.f; }
#pragma unroll
                for (int ai = 0; ai < 2; ++ai)
#pragma unroll
                    for (int m = 0; m < 4; ++m) { const f32x4 v0 = acc[ai][bj][m][0], v1 = acc[ai][bj][m][1];
                        const f32x2 a = gelu_pk((f32x2){v0[0], v0[1]}), b = gelu_pk((f32x2){v0[2], v0[3]}), c = gelu_pk((f32x2){v1[0], v1[1]}), d = gelu_pk((f32x2){v1[2], v1[3]});
                        s[0] += a.x; s[1] += a.y; s[2] += b.x; s[3] += b.y; s[4] += c.x; s[5] += c.y; s[6] += d.x; s[7] += d.y;
                        q[0] += a.x * a.x; q[1] += a.y * a.y; q[2] += b.x * b.x; q[3] += b.y * b.y; q[4] += c.x * c.x; q[5] += c.y * c.y; q[6] += d.x * d.x; q[7] += d.y * d.y;
                        u32x4 w; w.x = cvt_pk_bf16(a.x, a.y); w.y = cvt_pk_bf16(b.x, b.y); w.z = cvt_pk_bf16(c.x, c.y); w.w = cvt_pk_bf16(d.x, d.y);
                        *(u32x4*)(VT + ((size_t)chunk * GH + crow0 + ai * HALF + m * 16) * 128 + q0) = w;
                        asm volatile("" : "+v"(s[0]), "+v"(s[1]), "+v"(s[2]), "+v"(s[3]), "+v"(s[4]), "+v"(s[5]), "+v"(s[6]), "+v"(s[7]));
                        asm volatile("" : "+v"(q[0]), "+v"(q[1]), "+v"(q[2]), "+v"(q[3]), "+v"(q[4]), "+v"(q[5]), "+v"(q[6]), "+v"(q[7]) :: "memory"); }
#pragma unroll
                for (int j = 0; j < 8; ++j) {
#pragma unroll
                    for (int o = 1; o < 16; o <<= 1) { s[j] += __shfl_xor(s[j], o); q[j] += __shfl_xor(q[j], o); } }
                if (fr == 0) { float* pp = part + ((size_t)(ct * 2 + wr) * VT_COLS + chunk * 128 + q0) * 2;
#pragma unroll
                    for (int j = 0; j < 8; j += 2) *(f32x4*)(pp + 2 * j) = (f32x4){s[j], q[j], s[j + 1], q[j + 1]}; }
            }
            (void)lane;
        }
    }
};
struct EpiQKV {
    static constexpr bool PERM = true, AFTER_DRAIN = false;
    bf16_t* Q; bf16_t* KB; bf16_t* VB;
    __device__ __forceinline__ void operator()(const f32x4 (&acc)[2][2][4][2], const Unit& u, int wr, int wc, int fr, int fq) const {
        bf16_t* base; int ldc;
        if (u.pn < 4) { base = Q + (size_t)u.pm * BM * DM + u.pn * BM; ldc = DM; }
        else { const int kvrow0 = u.pm < 64 ? CTXL + u.pm * BM : (u.pm < 128 ? KVROWS + CTXL + (u.pm - 64) * BM : (u.pm - 128) * KVROWS);
               base = (u.pn == 4 ? KB : VB) + (size_t)kvrow0 * 256; ldc = 256; }
        base += (size_t)(wr * 64 + fr) * ldc + wc * 32 + 8 * fq;
#pragma unroll
        for (int ai = 0; ai < 2; ++ai)
#pragma unroll
            for (int m = 0; m < 4; ++m) { bf16_t* rowp = base + (size_t)(ai * HALF + m * 16) * ldc;
#pragma unroll
                for (int bj = 0; bj < 2; ++bj) { const f32x4 v0 = acc[ai][bj][m][0], v1 = acc[ai][bj][m][1];
                    u32x4 w; w.x = cvt_pk_bf16(v0[0], v0[1]); w.y = cvt_pk_bf16(v0[2], v0[3]); w.z = cvt_pk_bf16(v1[0], v1[1]); w.w = cvt_pk_bf16(v1[2], v1[3]);
                    *(u32x4*)(rowp + bj * HALF) = w; } }
    }
};
struct GmlpOrder {
    StaticOrder so; int p0;
    __device__ void init(int p0_, int np, int G, int c) { p0 = p0_; so.init(np * BM, 24 * BM, G, c); }
    __device__ bool next(int i, Unit& u) const { Unit v; if (!so.next(i, v)) return false;
        if (v.pn < 12) { u.pm = p0 + v.pm; u.pn = GIN_PAN0 + v.pn; } else { u.pm = GIN_PAN0 + v.pn; u.pn = p0 + v.pm; } return true; }
    __device__ __forceinline__ void a_ready(const Unit&) const {}
    __device__ __forceinline__ void done(const Unit&) const {}
};
struct ResidOrder {
    StaticOrder so; int ns, nkf;
    __device__ __forceinline__ void init(int ns_, int nkt_full, int G_, int c_) { ns = ns_; nkf = nkt_full; so.init(NPAN_LAT * BM, 4 * BM, G_, c_); }
    __device__ __forceinline__ bool next(int i, Unit& u) const {
        const int L = i * so.G + so.c; Unit v; v.pm = 0; v.pn = 0;
        const bool lat = so.next(i, v);
        const int e = L - 512, tile = e / (ns > 0 ? ns : 1), sl = e - tile * ns;
        const bool ok = lat || (e >= 0 && e < 8 * ns);
        u.pm = lat ? v.pm : 128 + (tile >> 2); u.pn = lat ? v.pn : (tile & 3); u.kt0 = lat ? 0 : 4 * sl; u.nkt = lat ? nkf : 4;
        return ok; }
    __device__ __forceinline__ void a_ready(const Unit&) const {}
    __device__ __forceinline__ void done(const Unit&) const {}
};
struct QkvOrder {
    StaticOrder so; int G, c;
    __device__ void init(int G_, int c_) { G = G_; c = c_; so.init(NPAN_LAT * BM, 6 * BM, G_, c_); }
    __device__ bool next(int i, Unit& u) const { const int L = i * G + c; if (L < 768) return so.next(i, u); if (L >= 772) return false;
        const int e = L - 768; u.pm = 128 + (e >> 1); u.pn = 4 + (e & 1); return true; }
    __device__ __forceinline__ void a_ready(const Unit&) const {}
    __device__ __forceinline__ void done(const Unit&) const {}
};
template <class Epi, class Sched, bool ALIGN_EPI = false, bool SP2 = false>
__device__ __forceinline__ void gemm_phase(PG8_LAS unsigned char* lds, const Gemm g, const Sched& S, const Epi& E) {
    const int tid = opaque_tid(), wid = __builtin_amdgcn_readfirstlane(tid >> 6), lane = tid & 63, wr = wid >> 2, wc = wid & 3, fr = lane & 15, fq = lane >> 4;
    const int K = g.K;
    unsigned voffA[2], voffB[2];
#pragma unroll
    for (int i = 0; i < 2; ++i) { int R, C; stage_rc(tid * 16 + i * 8192, R, C); const int Rb = Epi::PERM ? ((R & ~31) + perm32(R & 31)) : R;
        voffA[i] = (unsigned)(R * K + C) * 2u; voffB[i] = (unsigned)(Rb * K + C) * 2u; }
    const size_t kstep = (size_t)(BK * 2);
    const size_t hstep = (size_t)HALF * K * 2;
    const size_t tstep = 2 * hstep;
    const unsigned ldsw = (unsigned)wid * 1024u;
    const int aoff = lds_byte(wr * 64 + fr, fq * 8), boff = lds_byte(wc * 32 + fr, fq * 8);
#define PG8_SA(b, h) (((b) * 2 + (h)) * HTB)
#define PG8_SB(b, h) ((4 + (b) * 2 + (h)) * HTB)
#define PG8_STAGE(bufoff, gbase, voff) do { _Pragma("unroll") for (int _i = 0; _i < 2; ++_i) \
        __builtin_amdgcn_global_load_lds((const unsigned*)((const char*)(gbase) + (voff)[_i]), (PG8_LAS unsigned*)(lds + (bufoff) + ldsw + _i * 8192), 16, 0, 0); } while (0)
#define PG8_LDA(dst, b, h) do { _Pragma("unroll") for (int m = 0; m < 4; ++m) _Pragma("unroll") for (int k = 0; k < 2; ++k) dst[m][k] = *(const PG8_LAS bf16x8*)(lds + PG8_SA(b, h) + aoff + m * 2048 + k * 1024); } while (0)
#define PG8_LDB(dst, b, h) do { _Pragma("unroll") for (int n = 0; n < 2; ++n) _Pragma("unroll") for (int k = 0; k < 2; ++k) dst[n][k] = *(const PG8_LAS bf16x8*)(lds + PG8_SB(b, h) + boff + n * 2048 + k * 1024); } while (0)
#define PG8_MMA(ai, bj, At, Bt) do { __builtin_amdgcn_s_setprio(1); _Pragma("unroll") for (int m = 0; m < 4; ++m) _Pragma("unroll") for (int n = 0; n < 2; ++n) _Pragma("unroll") for (int k = 0; k < 2; ++k) \
        acc[ai][bj][m][n] = __builtin_amdgcn_mfma_f32_16x16x32_bf16(Bt[n][k], At[m][k], acc[ai][bj][m][n], 0, 0, 0); __builtin_amdgcn_s_setprio(0); } while (0)
#define PG8_WAIT_V(n) asm volatile("s_waitcnt vmcnt(" #n ")" ::: "memory")
#define PG8_WAIT_L(n) asm volatile("s_waitcnt lgkmcnt(" #n ")" ::: "memory")
#define PG8_BAR __builtin_amdgcn_s_barrier()
#define PG8_SCHED __builtin_amdgcn_sched_barrier(0)
    Unit cur, nxt; int ui = 0;
    cur.kt0 = 0; cur.nkt = K / BK;
    if (!S.next(0, cur)) return;
    f32x4 acc[2][2][4][2];
#pragma unroll
    for (int a = 0; a < 2; ++a)
#pragma unroll
        for (int b = 0; b < 2; ++b)
#pragma unroll
            for (int m = 0; m < 4; ++m)
#pragma unroll
                for (int n = 0; n < 2; ++n) acc[a][b][m][n] = (f32x4){0.f, 0.f, 0.f, 0.f};
    bf16x8 At[4][2], B0[2][2], B1[2][2];
    const char* cA = (const char*)g.A + (size_t)cur.pm * tstep + (size_t)cur.kt0 * kstep; const char* cB = (const char*)g.Bt + (size_t)cur.pn * tstep + (size_t)cur.kt0 * kstep;
    S.a_ready(cur);
    if constexpr (SP2) {
        PG8_STAGE(PG8_SB(0, 0), cB, voffB); PG8_STAGE(PG8_SB(0, 1), cB + hstep, voffB); PG8_STAGE(PG8_SA(0, 0), cA, voffA); PG8_STAGE(PG8_SA(0, 1), cA + hstep, voffA);
        if (wr == 1) PG8_BAR;
        PG8_WAIT_V(2); PG8_BAR;
        PG8_STAGE(PG8_SB(1, 0), cB + kstep, voffB); PG8_STAGE(PG8_SA(1, 0), cA + kstep, voffA); PG8_STAGE(PG8_SB(1, 1), cB + hstep + kstep, voffB);
        PG8_WAIT_V(6); PG8_BAR;
    } else {
        PG8_STAGE(PG8_SB(0, 0), cB, voffB); PG8_STAGE(PG8_SA(0, 0), cA, voffA); PG8_STAGE(PG8_SB(0, 1), cB + hstep, voffB); PG8_STAGE(PG8_SA(0, 1), cA + hstep, voffA);
        if (wr == 1) PG8_BAR;
        PG8_WAIT_V(4); PG8_BAR;
        PG8_STAGE(PG8_SB(1, 0), cB + kstep, voffB); PG8_STAGE(PG8_SA(1, 0), cA + kstep, voffA); PG8_STAGE(PG8_SB(1, 1), cB + hstep + kstep, voffB);
        PG8_WAIT_V(6); PG8_BAR;
    }
    for (;;) {
        nxt.kt0 = 0; nxt.nkt = K / BK;
        const bool has_next = S.next(ui + 1, nxt);
        const int nt = cur.nkt;
        const char* nA = has_next ? (const char*)g.A + (size_t)nxt.pm * tstep + (size_t)nxt.kt0 * kstep : cA; const char* nB = has_next ? (const char*)g.Bt + (size_t)nxt.pn * tstep + (size_t)nxt.kt0 * kstep : cB;
        for (int t = 0; t < nt; t += 2) {
            const bool last = (t == nt - 2);
            const char* a1 = cA + (size_t)(t + 1) * kstep;
            const char* a2 = last ? nA : cA + (size_t)(t + 2) * kstep; const char* b2 = last ? nB : cB + (size_t)(t + 2) * kstep;
            const char* a3 = a2 + kstep; const char* b3 = b2 + kstep;
            if (last && has_next) S.a_ready(nxt);
            if constexpr (SP2) {
            PG8_LDB(B0, 0, 0); PG8_LDB(B1, 0, 1); PG8_SCHED; PG8_LDA(At, 0, 0); PG8_STAGE(PG8_SA(1, 1), a1 + hstep, voffA);
            PG8_WAIT_V(8); PG8_WAIT_L(0); PG8_BAR; PG8_MMA(0, 0, At, B0); PG8_MMA(0, 1, At, B1); PG8_BAR; PG8_SCHED;
            PG8_LDA(At, 0, 1); PG8_STAGE(PG8_SB(0, 0), b2, voffB); PG8_STAGE(PG8_SB(0, 1), b2 + hstep, voffB); PG8_STAGE(PG8_SA(0, 0), a2, voffA);
            PG8_WAIT_V(8); PG8_WAIT_L(0); PG8_BAR; PG8_MMA(1, 0, At, B0); PG8_MMA(1, 1, At, B1); PG8_BAR; PG8_SCHED;
            PG8_LDB(B0, 1, 0); PG8_LDB(B1, 1, 1); PG8_SCHED; PG8_LDA(At, 1, 0); PG8_STAGE(PG8_SA(0, 1), a2 + hstep, voffA);
            PG8_WAIT_V(8); PG8_WAIT_L(0); PG8_BAR; PG8_MMA(0, 0, At, B0); PG8_MMA(0, 1, At, B1); PG8_BAR; PG8_SCHED;
            PG8_LDA(At, 1, 1); PG8_STAGE(PG8_SB(1, 0), b3, voffB); PG8_STAGE(PG8_SB(1, 1), b3 + hstep, voffB); PG8_STAGE(PG8_SA(1, 0), a3, voffA);
            PG8_WAIT_V(8); PG8_WAIT_L(0); PG8_BAR; PG8_MMA(1, 0, At, B0); PG8_MMA(1, 1, At, B1); PG8_BAR; PG8_SCHED;
            } else {
            PG8_LDB(B0, 0, 0); PG8_SCHED; PG8_LDA(At, 0, 0); PG8_STAGE(PG8_SA(1, 1), a1 + hstep, voffA);
            PG8_WAIT_L(8); PG8_BAR; PG8_WAIT_L(0); PG8_MMA(0, 0, At, B0); PG8_BAR; PG8_SCHED;
            PG8_LDB(B1, 0, 1); PG8_STAGE(PG8_SB(0, 0), b2, voffB);
            PG8_BAR; PG8_WAIT_L(0); PG8_MMA(0, 1, At, B1); PG8_BAR;
            PG8_LDA(At, 0, 1); PG8_STAGE(PG8_SA(0, 0), a2, voffA);
            PG8_BAR; PG8_WAIT_L(0); PG8_MMA(1, 0, At, B0); PG8_BAR; PG8_SCHED;
            PG8_STAGE(PG8_SB(0, 1), b2 + hstep, voffB);
            PG8_WAIT_V(6); PG8_BAR; PG8_MMA(1, 1, At, B1); PG8_BAR;
            PG8_LDB(B0, 1, 0); PG8_SCHED; PG8_LDA(At, 1, 0); PG8_STAGE(PG8_SA(0, 1), a2 + hstep, voffA);
            PG8_WAIT_L(8); PG8_BAR; PG8_WAIT_L(0); PG8_MMA(0, 0, At, B0); PG8_BAR; PG8_SCHED;
            PG8_LDB(B1, 1, 1); PG8_STAGE(PG8_SB(1, 0), b3, voffB);
            PG8_BAR; PG8_WAIT_L(0); PG8_MMA(0, 1, At, B1); PG8_BAR;
            PG8_LDA(At, 1, 1); PG8_STAGE(PG8_SA(1, 0), a3, voffA);
            PG8_BAR; PG8_WAIT_L(0); PG8_MMA(1, 0, At, B0); PG8_BAR; PG8_SCHED;
            PG8_STAGE(PG8_SB(1, 1), b3 + hstep, voffB);
            PG8_WAIT_V(6); PG8_BAR; PG8_MMA(1, 1, At, B1); PG8_BAR;
            }
        }
        if constexpr (ALIGN_EPI) { if (wr == 0) PG8_BAR; }
        if constexpr (!Epi::AFTER_DRAIN) { E(acc, cur, wr, wc, fr, fq); S.done(cur); }
        if (!has_next) break;
#pragma unroll
        for (int a = 0; a < 2; ++a)
#pragma unroll
            for (int b = 0; b < 2; ++b)
#pragma unroll
                for (int m = 0; m < 4; ++m)
#pragma unroll
                    for (int n = 0; n < 2; ++n) acc[a][b][m][n] = (f32x4){0.f, 0.f, 0.f, 0.f};
        cur = nxt; cA = nA; cB = nB; ++ui;
        if constexpr (ALIGN_EPI) { if (wr == 1) PG8_BAR; }
    }
    PG8_WAIT_V(0);
    if constexpr (!ALIGN_EPI) { if (wr == 0) PG8_BAR; }
    PG8_BAR;
    if constexpr (Epi::AFTER_DRAIN) { E.fused(acc, cur, wr, wc, fr, fq, lds, wid, lane); S.done(cur); }
#undef PG8_SA
#undef PG8_SB
#undef PG8_STAGE
#undef PG8_LDA
#undef PG8_LDB
#undef PG8_MMA
#undef PG8_WAIT_V
#undef PG8_WAIT_L
#undef PG8_BAR
#undef PG8_SCHED
}
}
namespace att {
using bf16 = __hip_bfloat16;
constexpr int D = 128, NW = 8, QBLK = 32, KVBLK = 64;
constexpr float SCALE = 0.088388347648318440f;
constexpr float THR = 8.f;
constexpr int SDEPTH = 2;
constexpr int LDQ = 1024, LDK = 256, LDO = 1024;
constexpr size_t SHM_V = KVBLK * D * 2, SHM_K = KVBLK * D * 2, SHM_ATTN = 2 * SHM_V + 2 * SHM_K + NW * 64 * 4;
using bf16x8 = __attribute__((ext_vector_type(8))) short;
using s16x4  = __attribute__((ext_vector_type(4))) short;
using f32x16 = __attribute__((ext_vector_type(16))) float;
using f32x8  = __attribute__((ext_vector_type(8))) float;
using u32x4  = __attribute__((ext_vector_type(4))) unsigned;
#define KSWZ(row, colB) ((row) * 256 + ((colB) ^ (((row) & 7) << 4)))
#define SBAR() __builtin_amdgcn_sched_barrier(0)
__device__ __forceinline__ int crow(int r, int hi) { return (r & 3) + 8 * (r >> 2) + 4 * hi; }
__device__ __forceinline__ unsigned cvtpk(float lo, float hi) {
  unsigned r; asm volatile("v_cvt_pk_bf16_f32 %0, %1, %2" : "=v"(r) : "v"(lo), "v"(hi)); return r;
}
template <typename TIn> struct Stage;
template <> struct Stage<bf16>  { using T = bf16x8;
  __device__ static __forceinline__ T ld8(const bf16* p) { return *reinterpret_cast<const bf16x8*>(p); }
  __device__ static __forceinline__ bf16x8 tobf(T x) { return x; } };
template <> struct Stage<float> { using T = f32x8;
  __device__ static __forceinline__ T ld8(const float* p) { return *reinterpret_cast<const f32x8*>(p); }
  __device__ static __forceinline__ bf16x8 tobf(T x) {
    u32x4 w = {cvtpk(x[0], x[1]), cvtpk(x[2], x[3]), cvtpk(x[4], x[5]), cvtpk(x[6], x[7])}; return *reinterpret_cast<bf16x8*>(&w); } };

__device__ __forceinline__ void partialSM(f32x16& p0, f32x16& p1, float& m_reg, float& mn, float& alpha) {
  constexpr float C = SCALE * 1.4426950408889634f;
  float pmax = p0[0]; for (int r = 1; r < 16; ++r) pmax = fmaxf(pmax, p0[r]); for (int r = 0; r < 16; ++r) pmax = fmaxf(pmax, p1[r]);
  { auto rr = __builtin_amdgcn_permlane32_swap(__float_as_uint(pmax), __float_as_uint(pmax), false, false);
    pmax = fmaxf(__uint_as_float(rr[0]), __uint_as_float(rr[1])); }
  if (__builtin_expect(__all(pmax - m_reg <= THR / SCALE), 1)) { mn = m_reg; alpha = 1.f; }
  else { mn = fmaxf(m_reg, pmax); alpha = __builtin_amdgcn_exp2f((m_reg - mn) * C); m_reg = mn; }
  float mnC = -mn * C;
  for (int r = 0; r < 16; ++r) p0[r] = fmaf(p0[r], C, mnC); for (int r = 0; r < 16; ++r) p1[r] = fmaf(p1[r], C, mnC);
  for (int r = 0; r < 16; ++r) p0[r] = __builtin_amdgcn_exp2f(p0[r]);
}
__device__ __forceinline__ void finishSM(f32x16& p0, f32x16& p1, float alpha, float& l_reg, bf16x8& pa0, bf16x8& pa1, bf16x8& pa2, bf16x8& pa3) {
  for (int r = 0; r < 16; ++r) p1[r] = __builtin_amdgcn_exp2f(p1[r]);
  float ps = 0; for (int r = 0; r < 16; ++r) ps += p0[r]; for (int r = 0; r < 16; ++r) ps += p1[r];
  { auto rr = __builtin_amdgcn_permlane32_swap(__float_as_uint(ps), __float_as_uint(ps), false, false);
    ps = __uint_as_float(rr[0]) + __uint_as_float(rr[1]); }
  l_reg = l_reg * alpha + ps;
#define PK4(P, BASE, OUT) do { unsigned a0 = cvtpk(P[BASE + 0], P[BASE + 1]), a1 = cvtpk(P[BASE + 2], P[BASE + 3]);   \
    unsigned b0 = cvtpk(P[BASE + 4], P[BASE + 5]), b1 = cvtpk(P[BASE + 6], P[BASE + 7]);                              \
    auto r0 = __builtin_amdgcn_permlane32_swap(a0, b0, false, false); auto r1 = __builtin_amdgcn_permlane32_swap(a1, b1, false, false); \
    u32x4 w = {r0[0], r1[0], r0[1], r1[1]}; OUT = *reinterpret_cast<bf16x8*>(&w); } while (0)
  PK4(p0, 0, pa0); PK4(p0, 8, pa1); PK4(p1, 0, pa2); PK4(p1, 8, pa3);
#undef PK4
}
__device__ __forceinline__ void qkt(f32x16& p0, f32x16& p1, const bf16* Ks, const bf16x8* qr, int r32, int hi) {
  p0 = f32x16{}; p1 = f32x16{};
  for (int d0 = 0; d0 < 8; ++d0) { int cb = (d0 * 16 + hi * 8) * 2;
    bf16x8 b0 = *reinterpret_cast<const bf16x8*>((const char*)Ks + KSWZ(r32, cb));
    bf16x8 b1 = *reinterpret_cast<const bf16x8*>((const char*)Ks + KSWZ(32 + r32, cb));
    p0 = __builtin_amdgcn_mfma_f32_32x32x16_bf16(b0, qr[d0], p0, 0, 0, 0);
    p1 = __builtin_amdgcn_mfma_f32_32x32x16_bf16(b1, qr[d0], p1, 0, 0, 0); }
}
__device__ __forceinline__ int v_st(int k, int c) { const int kk = (k & ~0xC) | ((k & 4) << 1) | ((k & 8) >> 1); return ((kk >> 3) * 4 + (c >> 5)) * 512 + ((kk & 7) * 32 + (c & 31)) * 2; }
__device__ __forceinline__ int v_rd_base(int lane) { return ((lane & 3) << 3) | (((lane >> 2) & 3) << 6) | (((lane >> 4) & 1) << 5) | (((lane >> 5) & 1) << 8); }
constexpr int v_rd_off(int d0, int ks, int half) { return d0 * 512 + ks * 4096 + half * 2048; }
template <int OFF> __device__ __forceinline__ s16x4 tr_read(int vb) {
  s16x4 r; asm volatile("ds_read_b64_tr_b16 %0, %1 offset:%2" : "=&v"(r) : "v"(vb), "i"(OFF) : "memory"); return r;
}
template <int D0> __device__ __forceinline__ void pv_one(f32x16& od, int vb, bf16x8 pa0, bf16x8 pa1, bf16x8 pa2, bf16x8 pa3) {
  const s16x4 l0 = tr_read<v_rd_off(D0, 0, 0)>(vb), h0 = tr_read<v_rd_off(D0, 0, 1)>(vb), l1 = tr_read<v_rd_off(D0, 1, 0)>(vb), h1 = tr_read<v_rd_off(D0, 1, 1)>(vb);
  const s16x4 l2 = tr_read<v_rd_off(D0, 2, 0)>(vb), h2 = tr_read<v_rd_off(D0, 2, 1)>(vb), l3 = tr_read<v_rd_off(D0, 3, 0)>(vb), h3 = tr_read<v_rd_off(D0, 3, 1)>(vb);
  asm volatile("s_waitcnt lgkmcnt(0)" ::: "memory"); SBAR();
#define PK(L, H) (bf16x8){L[0], L[1], L[2], L[3], H[0], H[1], H[2], H[3]}
  od = __builtin_amdgcn_mfma_f32_32x32x16_bf16(pa0, PK(l0, h0), od, 0, 0, 0);
  od = __builtin_amdgcn_mfma_f32_32x32x16_bf16(pa1, PK(l1, h1), od, 0, 0, 0);
  od = __builtin_amdgcn_mfma_f32_32x32x16_bf16(pa2, PK(l2, h2), od, 0, 0, 0);
  od = __builtin_amdgcn_mfma_f32_32x32x16_bf16(pa3, PK(l3, h3), od, 0, 0, 0);
#undef PK
}
__device__ __forceinline__ void pv_d0(f32x16* o, int vb, bf16x8 pa0, bf16x8 pa1, bf16x8 pa2, bf16x8 pa3) {
  pv_one<0>(o[0], vb, pa0, pa1, pa2, pa3); pv_one<1>(o[1], vb, pa0, pa1, pa2, pa3); pv_one<2>(o[2], vb, pa0, pa1, pa2, pa3); pv_one<3>(o[3], vb, pa0, pa1, pa2, pa3);
}
__device__ __forceinline__ void attn_dense_body(const bf16* __restrict__ Qb, const bf16* __restrict__ Kh, const bf16* __restrict__ Vh,
                                                bf16* __restrict__ Ob, int seq, char* lds) {
  using St = Stage<bf16>;
  const int tid = opaque_tid(), wid = tid >> 6, lane = tid & 63, r32 = lane & 31, hi = lane >> 5;
  bf16* V_lds = (bf16*)lds; bf16* K_lds = (bf16*)(lds + 2 * SHM_V);
  float* ws = (float*)(lds + 2 * SHM_V + 2 * SHM_K) + wid * 64; float* li_l = ws; float* al_l = ws + 32;
  float m_reg = -1e30f, l_reg = 0; f32x16 o[4] = {}; bf16x8 qr[8];
  const bf16* Qw = Qb + (long)(wid * QBLK + r32) * LDQ + hi * 8;
#pragma unroll
  for (int d0 = 0; d0 < 8; ++d0) qr[d0] = St::ld8(Qw + d0 * 16);
  const int sr = tid >> 4, sc = (tid & 15) * 8, vst0 = v_st(sr, sc), vst1 = v_st(32 + sr, sc);
  const int vb0 = (int)(uintptr_t)V_lds + v_rd_base(lane);
  struct { typename St::T vs0, vs1, ks0, ks1; } sr_[SDEPTH];
#define SLOAD(i, k0) do { sr_[i].vs0 = St::ld8(&Vh[(long)((k0) + sr) * LDK + sc]); sr_[i].vs1 = St::ld8(&Vh[(long)((k0) + 32 + sr) * LDK + sc]); \
    sr_[i].ks0 = St::ld8(&Kh[(long)((k0) + sr) * LDK + sc]); sr_[i].ks1 = St::ld8(&Kh[(long)((k0) + 32 + sr) * LDK + sc]); } while (0)
#define SWRITE(b, i) do { *(bf16x8*)((char*)V_lds + (b) * SHM_V + vst0) = St::tobf(sr_[i].vs0);          \
    *(bf16x8*)((char*)V_lds + (b) * SHM_V + vst1) = St::tobf(sr_[i].vs1); int kc = sc * 2;               \
    *(bf16x8*)((char*)K_lds + (b) * SHM_K + KSWZ(sr, kc)) = St::tobf(sr_[i].ks0);                       \
    *(bf16x8*)((char*)K_lds + (b) * SHM_K + KSWZ(32 + sr, kc)) = St::tobf(sr_[i].ks1); } while (0)
#define SWAIT() do { if constexpr (SDEPTH == 2) asm volatile("s_waitcnt vmcnt(4)" ::: "memory"); else asm volatile("s_waitcnt vmcnt(0)" ::: "memory"); } while (0)
#define RESC(a) do { if (__any((a) < 1.f)) { if (hi == 0) al_l[r32] = (a); asm volatile("s_waitcnt lgkmcnt(0)" ::: "memory"); \
    for (int d = 0; d < 4; ++d) for (int r = 0; r < 16; ++r) o[d][r] *= al_l[crow(r, hi)]; } } while (0)
  f32x16 pA0, pA1, pB0, pB1; float mnA, mnB, alA, alB; bf16x8 pa0, pa1, pa2, pa3; const int NT = seq / KVBLK;
  constexpr int SE = 0, SO = SDEPTH - 1;
  SLOAD(SE, 0); asm volatile("s_waitcnt vmcnt(0)" ::: "memory"); SWRITE(0, SE); __syncthreads();
  qkt(pA0, pA1, K_lds, qr, r32, hi); partialSM(pA0, pA1, m_reg, mnA, alA);
  SLOAD(SO, KVBLK); if constexpr (SDEPTH == 2) { if (2 < NT) SLOAD(SE, 2 * KVBLK); }
  SWAIT(); SWRITE(1, SO); __syncthreads();
  for (int j = 1; j + 1 < NT; j += 2) {
    SBAR(); qkt(pB0, pB1, (bf16*)((char*)K_lds + SHM_K), qr, r32, hi);
    finishSM(pA0, pA1, alA, l_reg, pa0, pa1, pa2, pa3); SBAR();
    SLOAD(SO, (j + SDEPTH) * KVBLK); SBAR();
    pv_d0(o, vb0, pa0, pa1, pa2, pa3); partialSM(pB0, pB1, m_reg, mnB, alB);
    __syncthreads(); SWAIT(); SWRITE(0, SE);
    RESC(alB); __syncthreads();
    SBAR(); qkt(pA0, pA1, K_lds, qr, r32, hi);
    finishSM(pB0, pB1, alB, l_reg, pa0, pa1, pa2, pa3); SBAR();
    if (SDEPTH == 1 || j + 3 < NT) SLOAD(SE, (j + 1 + SDEPTH) * KVBLK); SBAR();
    pv_d0(o, vb0 + (int)SHM_V, pa0, pa1, pa2, pa3); partialSM(pA0, pA1, m_reg, mnA, alA);
    __syncthreads(); SWAIT(); SWRITE(1, SO);
    RESC(alA); __syncthreads();
  }
  SBAR(); qkt(pB0, pB1, (bf16*)((char*)K_lds + SHM_K), qr, r32, hi);
  finishSM(pA0, pA1, alA, l_reg, pa0, pa1, pa2, pa3); SBAR();
  pv_d0(o, vb0, pa0, pa1, pa2, pa3); partialSM(pB0, pB1, m_reg, mnB, alB);
  __syncthreads(); RESC(alB);
  finishSM(pB0, pB1, alB, l_reg, pa0, pa1, pa2, pa3); SBAR();
  pv_d0(o, vb0 + (int)SHM_V, pa0, pa1, pa2, pa3);
  if (hi == 0) li_l[r32] = l_reg; asm volatile("s_waitcnt lgkmcnt(0)" ::: "memory");
  float rli[16];
#pragma unroll
  for (int r = 0; r < 16; ++r) rli[r] = __builtin_amdgcn_rcpf(li_l[crow(r, hi)]);
  bf16* Ow = Ob + (long)(wid * QBLK) * LDO;
#pragma unroll
  for (int r = 0; r < 16; ++r) { int orow = crow(r, hi);
    for (int d0 = 0; d0 < 4; ++d0) Ow[(long)orow * LDO + d0 * 32 + r32] = __float2bfloat16(o[d0][r] * rli[r]); }
  asm volatile("s_waitcnt vmcnt(0) lgkmcnt(0)" ::: "memory"); __syncthreads();
#undef SLOAD
#undef SWRITE
#undef SWAIT
#undef RESC
}
#undef SBAR
#undef KSWZ
}
#define LAS __attribute__((address_space(3)))
typedef unsigned short bf16u;
typedef float f32x4 __attribute__((ext_vector_type(4)));
typedef unsigned v4u __attribute__((ext_vector_type(4)));
typedef unsigned v2u __attribute__((ext_vector_type(2)));
typedef short bf16x8 __attribute__((ext_vector_type(8)));
constexpr int NWAVES = 8, NTHR = 512;
constexpr size_t MiB = 1u << 20;
constexpr size_t WS_MOD = 1 * MiB;
constexpr size_t WS_ROPE = WS_MOD + 512 * 1024;
constexpr size_t WS_XCTX = 2 * MiB;
constexpr size_t WS_STATS = 7 * MiB + 512 * 1024;
constexpr size_t WS_PART = 4 * MiB;
constexpr size_t WS_FFN_IN = 8 * MiB;
constexpr size_t WS_FFN_OUT = WS_FFN_IN + 44 * MiB;
constexpr size_t WS_GOUT = WS_FFN_OUT + 22 * MiB;
constexpr size_t WS_WQKV = WS_GOUT + 6 * MiB;
constexpr size_t WS_WO = WS_WQKV + 3 * MiB;
constexpr size_t WS_A = WS_WO + 2 * MiB;
constexpr size_t WS_GIN = WS_A + 65 * MiB;
constexpr size_t WS_R1 = WS_GIN + 12 * MiB;
constexpr size_t WS_R2 = WS_R1 + 195 * MiB;
constexpr size_t WS_CPART = WS_R2 + 99 * MiB;
constexpr size_t WS_END = WS_CPART + 24 * MiB;
static_assert(WS_A == 85 * MiB && WS_END == 480 * MiB, "ws map");
static_assert((size_t)MTOT * DM * 2 == 65 * MiB, "A size");
constexpr size_t R1_Q = 0, R1_K = 64 * MiB, R1_V = 64 * MiB + 17 * MiB;
constexpr int LDS_BYTES = 147456;

struct Params {
    const float* x; const float* c; const float* ctx; const float* c_ctx; const float* w_mod; const float* b_mod;
    const float* ln_g; const float* ln_b; const float* ffn_w_in; const float* ffn_w_out; const float* gmlp_w_in;
    const float* gmlp_ln_g; const float* gmlp_ln_b; const float* gmlp_w_s; const float* gmlp_b_s; const float* gmlp_w_out;
    const float* attn_w_qkv; const float* attn_q_norm; const float* attn_k_norm; const float* attn_w_o;
    float* out; unsigned char* ws; int ph_lo, ph_hi;
};

__device__ __forceinline__ unsigned f2bf(float f) { unsigned u = __builtin_bit_cast(unsigned, f); return (u + 0x7fffu + ((u >> 16) & 1u)) >> 16; }
__device__ __forceinline__ unsigned pk2(float lo, float hi) { unsigned r; asm volatile("v_cvt_pk_bf16_f32 %0, %1, %2" : "=v"(r) : "v"(lo), "v"(hi)); return r; }
__device__ __forceinline__ float bf_lo(unsigned w) { return __builtin_bit_cast(float, w << 16); }
__device__ __forceinline__ float bf_hi(unsigned w) { return __builtin_bit_cast(float, w & 0xffff0000u); }
__device__ __forceinline__ float wave_sum(float v) {
#pragma unroll
    for (int o = 1; o < 64; o <<= 1) v += __shfl_xor(v, o);
    return v;
}
__device__ __forceinline__ void transpose_item(const float* W, int K, int N, bf16u* WT, int mode, LAS float* scr, int item, int lane) {
    const int nblk = N / 64, kb = item / nblk, nb = item % nblk, k0 = 64 * kb, n0 = 64 * nb;
    int d0 = n0;
    if (mode == 1) { const int isu = n0 >= DFF, j = isu ? n0 - DFF : n0; d0 = (j >> 7) * 256 + isu * 128 + (j & 127); }
    const float* src = W + (size_t)k0 * N + n0 + lane;
    float t[64];
#pragma unroll
    for (int kk = 0; kk < 64; ++kk) t[kk] = src[(size_t)kk * N];
#pragma unroll
    for (int kk = 0; kk < 64; ++kk) scr[kk * 65 + lane] = t[kk];
    asm volatile("s_waitcnt lgkmcnt(0)" ::: "memory");
    const int c = lane & 7;
#pragma unroll
    for (int j = 0; j < 8; ++j) { const int n = (lane >> 3) + 8 * j; const LAS float* sp = scr + (8 * c) * 65 + n;
        v4u o; o.x = pk2(sp[0 * 65], sp[1 * 65]); o.y = pk2(sp[2 * 65], sp[3 * 65]); o.z = pk2(sp[4 * 65], sp[5 * 65]); o.w = pk2(sp[6 * 65], sp[7 * 65]);
        *(v4u*)(WT + (size_t)(d0 + n) * K + k0 + 8 * c) = o; }
    asm volatile("s_waitcnt lgkmcnt(0)" ::: "memory");
}

__device__ __forceinline__ void phase_prologue(const Params& p, LAS unsigned char* lds, int G) {
    const int tid = opaque_tid(), lane = tid & 63, wave = __builtin_amdgcn_readfirstlane(tid >> 6);
    unsigned char* ws = p.ws;
    LAS float* sc = (LAS float*)lds;
    LAS float* red = (LAS float*)(lds + 12288);
    for (int k = tid; k < 1024; k += NTHR) { const float a = p.c[k], b = p.c[1024 + k], d = p.c_ctx[k];
        sc[k] = a / (1.f + __expf(-a)); sc[1024 + k] = b / (1.f + __expf(-b)); sc[2048 + k] = d / (1.f + __expf(-d)); }
    __syncthreads();
    float* MOD = (float*)(ws + WS_MOD);
    for (int u = blockIdx.x; u < 288; u += G) {
        const int col0 = u * 64, l = col0 / NMOD, j = col0 % NMOD + lane;
        const float* wp = p.w_mod + (size_t)l * 1024 * NMOD + (size_t)(wave * 128) * NMOD + j;
        float a0 = 0.f, a1 = 0.f, a2 = 0.f;
#pragma unroll 4
        for (int k0 = 0; k0 < 128; k0 += 32) { float w[32];
#pragma unroll
            for (int k = 0; k < 32; ++k) w[k] = wp[(size_t)(k0 + k) * NMOD];
#pragma unroll
            for (int k = 0; k < 32; ++k) { const int kk = wave * 128 + k0 + k; a0 += sc[kk] * w[k]; a1 += sc[1024 + kk] * w[k]; a2 += sc[2048 + kk] * w[k]; } }
        red[(wave * 3 + 0) * 64 + lane] = a0; red[(wave * 3 + 1) * 64 + lane] = a1; red[(wave * 3 + 2) * 64 + lane] = a2;
        __syncthreads();
        if (tid < 192) { const int cnd = tid >> 6; float s = 0.f;
#pragma unroll
            for (int w = 0; w < 8; ++w) s += red[(w * 3 + cnd) * 64 + lane];
            MOD[(size_t)(l * 3 + cnd) * NMOD + j] = s + p.b_mod[l * NMOD + j]; }
        __syncthreads();
    }
    { const int g = blockIdx.x * NTHR + tid; if (g < 8192) { const int pos = g >> 5, jf = g & 31;
        const float fr = powf(10000.0f, -(float)jf / 32.0f); const float ang = (float)pos * fr; float sn, cs; sincosf(ang, &sn, &cs);
        float* T = (float*)(ws + WS_ROPE); T[2 * g] = cs; T[2 * g + 1] = sn; } }
    __syncthreads();
    LAS float* scr = (LAS float*)(lds + wave * 16640);
    const int gw = blockIdx.x * NWAVES + wave, NGW = G * NWAVES;
    constexpr int I_FI = 16 * 88, I_FO = 44 * 16, I_GI = 16 * 96, I_GO = 48 * 16, I_QKV = 16 * 24, I_WO = 16 * 16;
    constexpr int NITEMS = 4 * I_FI + 4 * I_FO + I_GI + I_GO + I_QKV + I_WO;
    for (int it = gw; it < NITEMS; it += NGW) {
        int r = it;
        if (r < 4 * I_FI) { const int w = r / I_FI; transpose_item(p.ffn_w_in + (size_t)w * 1024 * 5632, 1024, 5632, (bf16u*)(ws + WS_FFN_IN) + (size_t)w * 5632 * 1024, 1, scr, r % I_FI, lane); continue; } r -= 4 * I_FI;
        if (r < 4 * I_FO) { const int w = r / I_FO; transpose_item(p.ffn_w_out + (size_t)w * DFF * 1024, DFF, 1024, (bf16u*)(ws + WS_FFN_OUT) + (size_t)w * 1024 * DFF, 0, scr, r % I_FO, lane); continue; } r -= 4 * I_FO;
        if (r < I_GI) { transpose_item(p.gmlp_w_in, 1024, 6144, (bf16u*)(ws + WS_GIN), 0, scr, r, lane); continue; } r -= I_GI;
        if (r < I_GO) { transpose_item(p.gmlp_w_out, GH, 1024, (bf16u*)(ws + WS_GOUT), 0, scr, r, lane); continue; } r -= I_GO;
        if (r < I_QKV) { transpose_item(p.attn_w_qkv, 1024, QKVN, (bf16u*)(ws + WS_WQKV), 0, scr, r, lane); continue; } r -= I_QKV;
        transpose_item(p.attn_w_o, 1024, 1024, (bf16u*)(ws + WS_WO), 0, scr, r, lane);
    }
}

__device__ __forceinline__ void phase_rowpass(const float* src_lat, const float* src_ctx, float* dst_lat, float* dst_ctx, bool do_ln, const float* lng, const float* lnb,
                                              const float* mod, int ksh, int ksc, bf16u* A, int nrows, int G,
                                              const float* cpart, int cns, const float* cres, const float* cgate, float cgs, float* stats) {
    const int tid = opaque_tid(), lane = tid & 63, wave = tid >> 6;
    const int gw = blockIdx.x * NWAVES + wave, NGW = G * NWAVES;
    const int r0 = gw, r1 = nrows;
    if (r0 >= r1) return;
    f32x4 lg[4], lb[4], sh[4], sc[4];
#pragma unroll
    for (int j = 0; j < 4; ++j) { lg[j] = do_ln ? ((const f32x4*)lng)[lane + 64 * j] : (f32x4){1.f, 1.f, 1.f, 1.f}; lb[j] = do_ln ? ((const f32x4*)lnb)[lane + 64 * j] : (f32x4){0.f, 0.f, 0.f, 0.f};
        sh[j] = (f32x4){0.f, 0.f, 0.f, 0.f}; sc[j] = sh[j]; }
    int cur_cond = -1;
    f32x4 v[4], vn[4];
    { const bool isctx = r0 >= NLAT; const float* s = isctx ? src_ctx + (size_t)(r0 - NLAT) * DM : src_lat + (size_t)r0 * DM;
#pragma unroll
      for (int j = 0; j < 4; ++j) v[j] = ((const f32x4*)s)[lane + 64 * j]; }
    for (int r = r0; r < r1; r += NGW) {
        const bool isctx = r >= NLAT; const int cond = r < SEQL ? 0 : (r < NLAT ? 1 : 2);
        if (r + NGW < r1) { const bool nctx = r + NGW >= NLAT; const float* s = nctx ? src_ctx + (size_t)(r + NGW - NLAT) * DM : src_lat + (size_t)(r + NGW) * DM;
#pragma unroll
            for (int j = 0; j < 4; ++j) vn[j] = ((const f32x4*)s)[lane + 64 * j]; }
        if (mod && cond != cur_cond) { cur_cond = cond; const float* mp = mod + (size_t)cond * NMOD;
#pragma unroll
            for (int j = 0; j < 4; ++j) { sh[j] = ((const f32x4*)(mp + ksh * 1024))[lane + 64 * j]; sc[j] = ((const f32x4*)(mp + ksc * 1024))[lane + 64 * j] + 1.0f; } }
        if (isctx && cpart) {
            const float* rr = cres + (size_t)(r - NLAT) * DM;
#pragma unroll
            for (int j = 0; j < 4; ++j) { f32x4 a = (f32x4){0.f, 0.f, 0.f, 0.f};
                for (int sl = 0; sl < cns; ++sl) a += ((const f32x4*)(cpart + (size_t)sl * NCTXR * DM + (size_t)(r - NLAT) * DM))[lane + 64 * j];
                v[j] = ((const f32x4*)rr)[lane + 64 * j] * ALPHA_C + ((const f32x4*)cgate)[lane + 64 * j] * cgs * a; }
        }
        if (do_ln) {
            float sm = 0.f;
#pragma unroll
            for (int j = 0; j < 4; ++j) sm += (v[j].x + v[j].y) + (v[j].z + v[j].w);
            const float mean = wave_sum(sm) * (1.f / DM); float s2 = 0.f;
#pragma unroll
            for (int j = 0; j < 4; ++j) { v[j] = v[j] - mean; s2 += (v[j].x * v[j].x + v[j].y * v[j].y) + (v[j].z * v[j].z + v[j].w * v[j].w); }
            const float rstd = 1.f / sqrtf(wave_sum(s2) * (1.f / DM) + LN_EPS_C);
            float* d = isctx ? dst_ctx + (size_t)(r - NLAT) * DM : dst_lat + (size_t)r * DM;
            const bool wr_x = isctx || stats == nullptr;
            if (!wr_x && lane == 0) *(float2*)(stats + (size_t)r * 2) = make_float2(mean, rstd);
#pragma unroll
            for (int j = 0; j < 4; ++j) { v[j] = v[j] * rstd * lg[j] + lb[j]; if (wr_x) ((f32x4*)d)[lane + 64 * j] = v[j]; }
        }
        if (mod) {
            v2u* a = (v2u*)(A + (size_t)r * DM);
#pragma unroll
            for (int j = 0; j < 4; ++j) { const f32x4 o = v[j] * sc[j] + sh[j]; v2u w; w.x = pk2(o.x, o.y); w.y = pk2(o.z, o.w); a[lane + 64 * j] = w; }
        }
#pragma unroll
        for (int j = 0; j < 4; ++j) v[j] = vn[j];
    }
}

__device__ __forceinline__ void phase_spatial(const Params& p, LAS unsigned char* lds, int chunk0, int nchunks, int G) {
    const int tid = opaque_tid(), lane = tid & 63, wave = __builtin_amdgcn_readfirstlane(tid >> 6), fr = lane & 15, fq = lane >> 4;
    LAS float* mu = (LAS float*)lds; LAS float* rs = mu + 128; LAS float* s0a = mu + 256; LAS float* s1a = mu + 384;
    LAS unsigned char* wl = lds + 2048;
    const bf16u* VT = (const bf16u*)(p.ws + WS_R2); bf16u* U = (bf16u*)(p.ws + WS_R1); const float* part = (const float*)(p.ws + WS_PART);
    const int nunits = nchunks * 8;
    for (int un = blockIdx.x; un < nunits; un += G) {
        const int crel = un >> 3, g = un & 7, cabs = chunk0 + crel;
        __syncthreads();
        if (tid < 128) { float S = 0.f, Q = 0.f; const int col = crel * 128 + tid;
#pragma unroll
            for (int t = 0; t < 24; ++t) { const float2 pq = *(const float2*)(part + ((size_t)t * VT_COLS + col) * 2); S += pq.x; Q += pq.y; }
            const float mean = S * (1.f / GH); const float var = fmaxf(Q * (1.f / GH) - mean * mean, 0.f); mu[tid] = mean; rs[tid] = 1.f / sqrtf(var + LN_EPS_C); }
        const int cbase = g * 384 + wave * 48;
        const bf16u* vt = VT + ((size_t)crel * GH + cbase) * 128;
        bf16x8 vf[3][4];
#pragma unroll
        for (int cb = 0; cb < 3; ++cb)
#pragma unroll
            for (int ks = 0; ks < 4; ++ks) vf[cb][ks] = *(const bf16x8*)(vt + (cb * 16 + fr) * 128 + ks * 32 + fq * 8);
        bf16u* ubase = U + (size_t)(cabs * 128 + fr) * GH + cbase + 4 * fq;
        v2u uu[8][3];
#pragma unroll
        for (int pb = 0; pb < 8; ++pb)
#pragma unroll
            for (int cb = 0; cb < 3; ++cb) uu[pb][cb] = *(const v2u*)(ubase + (size_t)(pb * 16) * GH + cb * 16);
        f32x4 lg[3], lb[3];
#pragma unroll
        for (int cb = 0; cb < 3; ++cb) { lg[cb] = *(const f32x4*)(p.gmlp_ln_g + cbase + cb * 16 + 4 * fq); lb[cb] = *(const f32x4*)(p.gmlp_ln_b + cbase + cb * 16 + 4 * fq); }
        float bsv[8];
#pragma unroll
        for (int pb = 0; pb < 8; ++pb) bsv[pb] = p.gmlp_b_s[g * 128 + pb * 16 + fr];
        const int pw = tid >> 2, qs = (tid & 3) * 32;
        const float* wrow = p.gmlp_w_s + ((size_t)g * 128 + pw) * 128 + qs;
        f32x4 wv[8];
#pragma unroll
        for (int i = 0; i < 8; ++i) wv[i] = *(const f32x4*)(wrow + 4 * i);
        __syncthreads();
        { float s0 = 0.f, s1 = 0.f;
#pragma unroll
          for (int i = 0; i < 4; ++i) { const int q0 = qs + 8 * i;
              const f32x4 r0 = *(const LAS f32x4*)(rs + q0), r1 = *(const LAS f32x4*)(rs + q0 + 4), m0 = *(const LAS f32x4*)(mu + q0), m1 = *(const LAS f32x4*)(mu + q0 + 4);
              const f32x4 w0 = wv[2 * i], w1 = wv[2 * i + 1]; const f32x4 a = w0 * r0, b = w1 * r1;
              v4u w; w.x = pk2(a.x, a.y); w.y = pk2(a.z, a.w); w.z = pk2(b.x, b.y); w.w = pk2(b.z, b.w);
              s0 += (w0.x + w0.y) + (w0.z + w0.w) + (w1.x + w1.y) + (w1.z + w1.w);
              s1 += bf_lo(w.x) * m0.x + bf_hi(w.x) * m0.y + bf_lo(w.y) * m0.z + bf_hi(w.y) * m0.w + bf_lo(w.z) * m1.x + bf_hi(w.z) * m1.y + bf_lo(w.w) * m1.z + bf_hi(w.w) * m1.w;
              *(LAS v4u*)(wl + pw * 272 + q0 * 2) = w; }
          s0 += __shfl_xor(s0, 1); s0 += __shfl_xor(s0, 2); s1 += __shfl_xor(s1, 1); s1 += __shfl_xor(s1, 2);
          if ((tid & 3) == 0) { s0a[pw] = s0; s1a[pw] = s1; } }
        __syncthreads();
#pragma unroll
        for (int pb = 0; pb < 8; ++pb) {
            const int pr = pb * 16 + fr;
            bf16x8 wf[4];
#pragma unroll
            for (int ks = 0; ks < 4; ++ks) wf[ks] = *(const LAS bf16x8*)(wl + pr * 272 + (ks * 32 + fq * 8) * 2);
            const float s0 = s0a[pr], s1 = s1a[pr];
            f32x4 acc[3];
#pragma unroll
            for (int cb = 0; cb < 3; ++cb) { acc[cb] = (f32x4){0.f, 0.f, 0.f, 0.f};
#pragma unroll
                for (int ks = 0; ks < 4; ++ks) acc[cb] = __builtin_amdgcn_mfma_f32_16x16x32_bf16(vf[cb][ks], wf[ks], acc[cb], 0, 0, 0); }
#pragma unroll
            for (int cb = 0; cb < 3; ++cb) { const v2u u2 = uu[pb][cb];
                const f32x4 val = lg[cb] * (acc[cb] - s1) + lb[cb] * s0 + bsv[pb];
                v2u o; o.x = pk2(bf_lo(u2.x) * val.x, bf_hi(u2.x) * val.y); o.y = pk2(bf_lo(u2.y) * val.z, bf_hi(u2.y) * val.w);
                *(v2u*)(ubase + (size_t)(pb * 16) * GH + cb * 16) = o; }
        }
    }
}

__device__ __forceinline__ void phase_qknorm(const Params& p, int G) {
    const int tid = opaque_tid(), lane = tid & 63, wave = tid >> 6, k = lane & 31, hsel = lane >> 5;
    const int gw = blockIdx.x * NWAVES + wave, NGW = G * NWAVES;
    bf16u* Q = (bf16u*)(p.ws + WS_R1 + R1_Q); bf16u* KB = (bf16u*)(p.ws + WS_R1 + R1_K);
    const float* T = (const float*)(p.ws + WS_ROPE);
    const float g1a = p.attn_q_norm[2 * k], g1b = p.attn_q_norm[2 * k + 1], g2a = p.attn_q_norm[64 + 2 * k], g2b = p.attn_q_norm[65 + 2 * k];
    const float h1a = p.attn_k_norm[2 * k], h1b = p.attn_k_norm[2 * k + 1], h2a = p.attn_k_norm[64 + 2 * k], h2b = p.attn_k_norm[65 + 2 * k];
    const int jf = (2 * k) & 31;
    constexpr int NK = 2 * KVROWS;
    for (int it = gw; it < NLAT + NK; it += NGW) {
        const bool isq = it < NLAT;
        bf16u* base; int t; bool rope = true; int np;
        if (isq) { base = Q + (size_t)it * DM + hsel * 128; t = it & (SEQL - 1); np = 4; }
        else { const int kr = it - NLAT; const int rb = kr % KVROWS; base = KB + (size_t)kr * 256 + hsel * 128; rope = rb >= CTXL; t = rb - CTXL; np = 1; }
        const float ga = isq ? g1a : h1a, gb = isq ? g1b : h1b, gc = isq ? g2a : h2a, gd = isq ? g2b : h2b;
        unsigned w1[4], w2[4];
#pragma unroll
        for (int hp = 0; hp < 4; ++hp) if (hp < np) { w1[hp] = *(const unsigned*)(base + hp * 256 + 2 * k); w2[hp] = *(const unsigned*)(base + hp * 256 + 64 + 2 * k); }
        f32x4 cs = (f32x4){1.f, 0.f, 1.f, 0.f};
        if (rope) { const int pos = k < 16 ? (t >> 6) : (t & 63); cs = *(const f32x4*)(T + ((size_t)pos * 32 + jf) * 2); }
#pragma unroll
        for (int hp = 0; hp < 4; ++hp) if (hp < np) {
            float x1a = bf_lo(w1[hp]), x1b = bf_hi(w1[hp]), x2a = bf_lo(w2[hp]), x2b = bf_hi(w2[hp]);
            float ss = x1a * x1a + x1b * x1b + x2a * x2a + x2b * x2b;
#pragma unroll
            for (int o = 1; o < 32; o <<= 1) ss += __shfl_xor(ss, o);
            const float rstd = 1.f / sqrtf(ss * (1.f / 128.f) + RMS_EPS_C);
            x1a *= rstd * ga; x1b *= rstd * gb; x2a *= rstd * gc; x2b *= rstd * gd;
            const float y1a = x1a * cs.x - x2a * cs.y, y2a = x2a * cs.x + x1a * cs.y, y1b = x1b * cs.z - x2b * cs.w, y2b = x2b * cs.z + x1b * cs.w;
            *(unsigned*)(base + hp * 256 + 2 * k) = pk2(y1a, y1b); *(unsigned*)(base + hp * 256 + 64 + 2 * k) = pk2(y2a, y2b); }
    }
}

__device__ __forceinline__ void phase_attn(const Params& p, unsigned char* lds_generic, int G) {
    const att::bf16* Q = (const att::bf16*)(p.ws + WS_R1 + R1_Q); const att::bf16* KB = (const att::bf16*)(p.ws + WS_R1 + R1_K); const att::bf16* VB = (const att::bf16*)(p.ws + WS_R1 + R1_V);
    att::bf16* O = (att::bf16*)(p.ws + WS_R2);
    for (int L = blockIdx.x; L < 1024; L += G) {
        const int b = L >> 9, kvh = (L >> 8) & 1, hq = L & 3, qb = (L >> 2) & 63, h = kvh * 4 + hq;
        const size_t q0 = ((size_t)b * SEQL + (size_t)qb * 256) * DM + h * 128, k0 = (size_t)b * KVROWS * 256 + kvh * 128;
        att::attn_dense_body(Q + q0, KB + k0, VB + k0, O + q0, KVROWS, (char*)lds_generic);
    }
}

#define XB_TMO      128
#define XB_XCNT(j)  (256  + 64 * (j))
#define XB_XSUB(j)  (1280 + 64 * (j))
#define XB_XGEN(j)  (2304 + 64 * (j))
#define XB_TOP      3328
#define XB_TOPGEN   3392
#define XCD_BAR_WORDS 3456
#define XB_SPIN_CAP (1u << 18)

__device__ __forceinline__ unsigned xb_ld(unsigned* p)              { return __hip_atomic_load(p, __ATOMIC_RELAXED, __HIP_MEMORY_SCOPE_AGENT); }
__device__ __forceinline__ unsigned xb_add(unsigned* p, unsigned v) { return __hip_atomic_fetch_add(p, v, __ATOMIC_RELAXED, __HIP_MEMORY_SCOPE_AGENT); }
__device__ __forceinline__ unsigned xb_xcc_id() { return (unsigned)__builtin_amdgcn_s_getreg((3 << 11) | 20) & 0xFu; }
#define XB_SPIN(cond, bar) do { unsigned _sp = 0; while (cond) { __builtin_amdgcn_s_sleep(1); \
    if ((++_sp & 255u) == 0u) { if (xb_ld(&(bar)[XB_TMO])) break; if (_sp > XB_SPIN_CAP) { atomicAdd(&(bar)[XB_TMO], 1u); break; } } } } while (0)

struct XcdBarrier {
    unsigned* bar; unsigned x;
    volatile LAS unsigned* st;
};

__device__ __forceinline__ XcdBarrier xcd_barrier_post(unsigned* bar, volatile LAS unsigned* st) {
    XcdBarrier b; b.bar = bar; b.x = xb_xcc_id(); b.st = st;
    if (threadIdx.x == 0) (void)xb_add(&bar[XB_XCNT(b.x)], 1u);
    return b;
}
__device__ __forceinline__ void xcd_barrier_complete(unsigned* bar, unsigned x, unsigned& nloc, unsigned& nx) {
    const unsigned G = gridDim.x * gridDim.y * gridDim.z;
    unsigned sum, cnt, mine, sp = 0u;
    for (;;) {
        sum = 0u; cnt = 0u; mine = 0u;
#pragma unroll
        for (unsigned j = 0; j < 16; ++j) { const unsigned c = xb_ld(&bar[XB_XCNT(j)]); sum += c; cnt += (c > 0u) ? 1u : 0u; mine = (j == x) ? c : mine; }
        if (sum == G) break;
        __builtin_amdgcn_s_sleep(1);
        if ((++sp & 255u) == 0u) { if (xb_ld(&bar[XB_TMO])) break; if (sp > XB_SPIN_CAP) { atomicAdd(&bar[XB_TMO], 1u); break; } }
    }
    nloc = mine > 0u ? mine : 1u; nx = cnt > 0u ? cnt : 1u;
}

__device__ __forceinline__ void xcd_barrier(const XcdBarrier& b) {
    asm volatile("s_waitcnt vmcnt(0)" ::: "memory");
    __syncthreads();
    if (threadIdx.x == 0) {
        unsigned* bar = b.bar;
        __builtin_amdgcn_s_waitcnt(0);
        unsigned nloc = b.st[0], nx = b.st[1];
        if (nloc == 0u) { xcd_barrier_complete(bar, b.x, nloc, nx); b.st[0] = nloc; b.st[1] = nx; }
        const unsigned old = xb_add(&bar[XB_XSUB(b.x)], 1u);
        const unsigned gen = old / nloc;
        if (old + 1u == (gen + 1u) * nloc) {
            __builtin_amdgcn_fence(__ATOMIC_RELEASE, "agent");
            asm volatile("s_waitcnt vmcnt(0)" ::: "memory");
            const unsigned og = xb_add(&bar[XB_TOP], 1u);
            const unsigned tg = og / nx;
            if (og + 1u == (tg + 1u) * nx) xb_add(&bar[XB_TOPGEN], 1u);
            else XB_SPIN(xb_ld(&bar[XB_TOPGEN]) == tg, bar);
            __builtin_amdgcn_fence(__ATOMIC_ACQUIRE, "agent");
            xb_add(&bar[XB_XGEN(b.x)], 1u);
            asm volatile("s_waitcnt vmcnt(0)" ::: "memory");
        } else {
            XB_SPIN(xb_ld(&bar[XB_XGEN(b.x)]) == gen, bar);
            __builtin_amdgcn_fence(__ATOMIC_ACQUIRE, "agent");
            asm volatile("s_waitcnt vmcnt(0)" ::: "memory");
        }
    }
    __syncthreads();
}

enum { T_PRO = 0, T_ROW, T_FFN1, T_RESID, T_GIN, T_SPAT, T_QKV, T_ROPE, T_ATTN };
constexpr int NPHASE = 25;
__global__ void __launch_bounds__(NTHR, 2) mega(Params p) {
    extern __shared__ __attribute__((aligned(16))) unsigned char lds[];
    LAS unsigned char* ldsl = (LAS unsigned char*)lds;
    const int G = gridDim.x;
    unsigned char* ws = p.ws;
    volatile LAS unsigned* MISC = (volatile LAS unsigned*)(ldsl + 147200);
    if (threadIdx.x < 64) MISC[threadIdx.x] = 0u;
    __syncthreads();
    XcdBarrier bar = xcd_barrier_post((unsigned*)ws, MISC + 8);
    float* MOD = (float*)(ws + WS_MOD);
    bf16u* A = (bf16u*)(ws + WS_A); bf16u* R1 = (bf16u*)(ws + WS_R1); bf16u* R2 = (bf16u*)(ws + WS_R2);
    float* XL = p.out; float* XC = (float*)(ws + WS_XCTX);
    bool dup_done = false; (void)dup_done;
    for (int ph = p.ph_lo; ph < p.ph_hi; ++ph) {
        int type = T_ROW, layer = 0, a0 = 0, a1 = 0, a2 = 0, rows = MTOT;
        int cns = 0, cgl = 0, cgk = 0, cfirst = 0;
        switch (ph) {
            case 0: type = T_PRO; break;
            case 1: type = T_ROW; layer = 0; a0 = -1; a1 = 0; break;
            case 2: type = T_FFN1; a0 = 0; break;
            case 3: type = T_RESID; a0 = 0; layer = 0; a1 = 2; a2 = 1; break;
            case 4: type = T_ROW; layer = 0; a0 = 0; a1 = 3; cns = 11; cgl = 0; cgk = 2; cfirst = 1; break;
            case 5: type = T_GIN; a0 = 0; break;
            case 6: type = T_SPAT; a0 = 0; break;
            case 7: type = T_GIN; a0 = 1; break;
            case 8: type = T_SPAT; a0 = 1; break;
            case 9: type = T_RESID; a0 = 4; layer = 0; a1 = 5; cns = 1; cgk = 0; break;
            case 10: type = T_ROW; layer = 0; a0 = 1; a1 = 6; cns = 12; cgl = 0; cgk = 5; break;
            case 11: type = T_FFN1; a0 = 1; break;
            case 12: type = T_RESID; a0 = 1; layer = 0; a1 = 8; cns = 1; cgk = 1; break;
            case 13: type = T_ROW; layer = 1; a0 = 2; a1 = 0; cns = 11; cgl = 0; cgk = 8; break;
            case 14: type = T_FFN1; a0 = 2; break;
            case 15: type = T_RESID; a0 = 2; layer = 1; a1 = 2; cns = 1; cgk = 2; break;
            case 16: type = T_ROW; layer = 1; a0 = 3; a1 = 3; cns = 11; cgl = 1; cgk = 2; break;
            case 17: type = T_QKV; break;
            case 18: type = T_ROPE; break;
            case 19: type = T_ATTN; break;
            case 20: type = T_RESID; a0 = 5; layer = 1; a1 = 5; rows = NLAT; cns = 1; cgk = 3; break;
            case 21: type = T_ROW; layer = 1; a0 = 4; a1 = 6; rows = NLAT; break;
            case 22: type = T_FFN1; a0 = 3; rows = NLAT; break;
            case 23: type = T_RESID; a0 = 3; layer = 1; a1 = 8; rows = NLAT; cns = 1; cgk = 4; break;
            default: type = T_ROW; layer = 1; a0 = 5; a1 = -1; rows = NLAT; break;
        }
#ifndef PHM
#define PHM 0x1ff
#endif
        if (type == T_PRO) { if (PHM & 1) phase_prologue(p, ldsl, G); }
        else if (type == T_ROW) { if (PHM & 2) {
            const bool first = (a0 < 0);
            phase_rowpass(first ? p.x : XL, first ? p.ctx : XC, XL, XC, !first, p.ln_g + (first ? 0 : a0) * DM, p.ln_b + (first ? 0 : a0) * DM,
                          a1 >= 0 ? MOD + (size_t)layer * 3 * NMOD : nullptr, a1, a1 + 1, A, rows, G,
                          cns ? (const float*)(ws + WS_CPART) : nullptr, cns, cfirst ? p.ctx : XC, MOD + (size_t)(cgl * 3 + 2) * NMOD + cgk * 1024, cgk == 5 ? 1.0f : 0.5f, a1 >= 0 ? (float*)(ws + WS_STATS) : nullptr); }
        } else if (type == T_FFN1) { if (PHM & 4) {
            pg8::Gemm g{A, (const bf16u*)(ws + WS_FFN_IN) + (size_t)a0 * 5632 * 1024, rows, 5632, 1024};
            pg8::StaticOrder S; S.init(rows, 5632, G, (int)blockIdx.x);
            pg8::EpiSwiglu E{R1};
            pg8::gemm_phase<pg8::EpiSwiglu, pg8::StaticOrder, true, true>(ldsl, g, S, E); }
        } else if (type == T_RESID) { if (PHM & 8) {
            const bf16u* Ain = a0 == 5 ? R2 : R1; const int K = a0 < 4 ? DFF : (a0 == 4 ? GH : DM);
            const bf16u* W = a0 < 4 ? (const bf16u*)(ws + WS_FFN_OUT) + (size_t)a0 * 1024 * DFF : (a0 == 4 ? (const bf16u*)(ws + WS_GOUT) : (const bf16u*)(ws + WS_WO));
            pg8::Gemm g{Ain, W, rows, 1024, K};
            pg8::ResidOrder S; S.init(rows == MTOT ? K / 256 : 0, K / 64, G, (int)blockIdx.x);
            pg8::EpiResid E{a2 ? p.x : XL, a2 ? p.ctx : XC, XL, XC, MOD + (size_t)layer * 3 * NMOD + a1 * 1024, (a1 == 5) ? 1.0f : 0.5f, (float*)(ws + WS_CPART),
                              cns ? (const float*)(ws + WS_STATS) : nullptr, p.ln_g + cgk * DM, p.ln_b + cgk * DM};
            pg8::gemm_phase<pg8::EpiResid, pg8::ResidOrder, true, true>(ldsl, g, S, E); }
        } else if (type == T_GIN) { if (PHM & 16) {
            const int p0 = a0 ? 64 : 0, np = a0 ? 66 : 64;
            pg8::Gemm g{A, A, 0, 0, 1024};
            pg8::GmlpOrder S; S.init(p0, np, G, (int)blockIdx.x);
            pg8::EpiGmlp E{R1, R2, (float*)(ws + WS_PART), p0};
            pg8::gemm_phase<pg8::EpiGmlp, pg8::GmlpOrder, true, true>(ldsl, g, S, E); }
        } else if (type == T_SPAT) {
            if (PHM & 32) phase_spatial(p, ldsl, a0 ? 128 : 0, a0 ? 132 : 128, G);
        } else if (type == T_QKV) { if (PHM & 64) {
            pg8::Gemm g{A, (const bf16u*)(ws + WS_WQKV), 0, 0, 1024};
            pg8::QkvOrder S; S.init(G, (int)blockIdx.x);
            pg8::EpiQKV E{(bf16u*)(ws + WS_R1 + R1_Q), (bf16u*)(ws + WS_R1 + R1_K), (bf16u*)(ws + WS_R1 + R1_V)};
            pg8::gemm_phase<pg8::EpiQKV, pg8::QkvOrder, true, true>(ldsl, g, S, E); }
        } else if (type == T_ROPE) { if (PHM & 128) phase_qknorm(p, G); }
        else { if (PHM & 256) phase_attn(p, lds, G); }
        if (ph + 1 < p.ph_hi) { if (ph == 0) cg::this_grid().sync(); else xcd_barrier(bar); }
#if defined(PROBE_SYNC2)
        if (ph + 1 < p.ph_hi && ph != 0) xcd_barrier(bar);
#endif
#if defined(PROBE_DUP)
        if (ph == (PROBE_DUP) && !dup_done) { dup_done = true; --ph; }
#endif
#if defined(PROBE_DUP_HI)
        if (ph == (PROBE_DUP_HI) && !dup_done) { dup_done = true; ph = (PROBE_DUP_LO) - 1; }
#endif
    }
}

#ifndef MK_N_LAUNCHES
#define MK_N_LAUNCHES 1
#endif
extern "C" void kernel_launch(void* const* d_in, const int* in_sizes, int n_in, void* d_out, int out_size, void* d_ws, size_t ws_size, hipStream_t stream) {
    static int grid = 0;
    if (grid == 0) {
        if (n_in != 20 || out_size != NLAT * DM || ws_size < WS_END) { fprintf(stderr, "kernel_launch: unexpected shapes n_in %d out %d ws %zu\n", n_in, out_size, ws_size); grid = -1; return; }
        int dev = 0, cus = 0, per_cu = 0;
        hipGetDevice(&dev); hipDeviceGetAttribute(&cus, hipDeviceAttributeMultiprocessorCount, dev);
        if (hipFuncSetAttribute((const void*)mega, hipFuncAttributeMaxDynamicSharedMemorySize, LDS_BYTES) != hipSuccess) { fprintf(stderr, "kernel_launch: hipFuncSetAttribute failed\n"); grid = -1; return; }
        hipOccupancyMaxActiveBlocksPerMultiprocessor(&per_cu, (const void*)mega, NTHR, LDS_BYTES);
        if (per_cu < 1) { fprintf(stderr, "kernel_launch: occupancy query says %d blocks per CU\n", per_cu); per_cu = 1; }
        (void)hipGetLastError();
        grid = cus;
    }
    if (grid < 0) return;
    Params p{};
    const float** pp = (const float**)&p;
    for (int i = 0; i < 20; ++i) pp[i] = (const float*)d_in[i];
    p.out = (float*)d_out; p.ws = (unsigned char*)d_ws;
#if MK_N_LAUNCHES == 1
    p.ph_lo = 0; p.ph_hi = NPHASE;
    if (hipMemsetAsync(d_ws, 0, 16384, stream) != hipSuccess) { fprintf(stderr, "kernel_launch: memset failed\n"); return; }
    void* args[] = {&p};
    hipError_t e = hipLaunchCooperativeKernel((const void*)mega, dim3(grid), dim3(NTHR), args, LDS_BYTES, stream);
    if (e != hipSuccess) fprintf(stderr, "cooperative launch failed: %s (grid %d)\n", hipGetErrorString(e), grid);
#else
    for (int ph = 0; ph < NPHASE; ++ph) { p.ph_lo = ph; p.ph_hi = ph + 1; hipLaunchKernelGGL(mega, dim3(grid), dim3(NTHR), LDS_BYTES, stream, p); }
#endif
}
```
